# Optimizing an MI355X kernel written in HIP

```python
import math
import jax, jax.numpy as jnp
from jax import lax
import numpy as np

D_MODEL = 1024
BATCH = 4
SEQ = 8192
DEPTH = 2

N_MEM = 256
GROUP_WIDTH = 512
N_GROUPS = 3
MIX_WIDTH = N_GROUPS * GROUP_WIDTH
ATT_HEADS = 8
ATT_HEAD_DIM = GROUP_WIDTH // ATT_HEADS
MOBA_BLOCK = 256
MOBA_TOPK = 3
Q_CHUNK = 128
LRU_HEADS = 8
LRU_HEAD_DIM = GROUP_WIDTH // LRU_HEADS
LRU_CONV = 4
LRU_C = 8.0
SC_CONV = 3
XATTN_HEADS = 4
XATTN_HEAD_DIM = D_MODEL // XATTN_HEADS
N_IN_SPLITS = 10
IN_COLS = N_IN_SPLITS * GROUP_WIDTH
DN_ALPHA = (2.0 * DEPTH) ** 0.25
DN_BETA = (8.0 * DEPTH) ** -0.25
LN_EPS = 1e-5
RMS_EPS = 1e-6

kernel_name = 'hymba_moba_rglru_shortconv_deepnorm'


def layer_norm(x, g, b):
    xf = x.astype(jnp.float32)
    mu = jnp.mean(xf, axis=-1, keepdims=True)
    var = jnp.mean(jnp.square(xf - mu), axis=-1, keepdims=True)
    return ((xf - mu) * lax.rsqrt(var + LN_EPS) * g.astype(jnp.float32) + b.astype(jnp.float32)).astype(x.dtype)


def group_rms_norm(y, g):
    yf = y.astype(jnp.float32)
    r = lax.rsqrt(jnp.mean(yf * yf, axis=-1, keepdims=True) + RMS_EPS)
    return (yf * r * g.astype(jnp.float32)).astype(y.dtype)


def causal_dwconv(x, w):
    k, c = w.shape
    return lax.conv_general_dilated(
        x, w[:, None, :].astype(x.dtype), window_strides=(1,), padding=[(k - 1, 0)],
        dimension_numbers=('NWC', 'WIO', 'NWC'), feature_group_count=c)


def moba_attention(q, k, v):
    b, h, s, dh = q.shape
    n_blk = -(-s // MOBA_BLOCK)
    s_pad = n_blk * MOBA_BLOCK
    pad = ((0, 0), (0, 0), (0, s_pad - s), (0, 0))
    k_blocks = jnp.pad(k, pad).reshape(b, h, n_blk, MOBA_BLOCK, dh)
    v_blocks = jnp.pad(v, pad).reshape(b, h, n_blk, MOBA_BLOCK, dh)
    k_mean = jnp.mean(k_blocks.astype(jnp.float32), axis=3).astype(k.dtype)
    n_sel = min(MOBA_TOPK, n_blk)
    scale = dh ** -0.5
    blk_ids = jnp.arange(n_blk)
    gather = jax.vmap(jax.vmap(lambda blocks, idx: blocks[idx]))

    def chunk(ci):
        start = ci * Q_CHUNK
        qc = lax.dynamic_slice_in_dim(q, start, Q_CHUNK, axis=2)
        own = start // MOBA_BLOCK
        q_pos = start + jnp.arange(Q_CHUNK)
        gate = jnp.einsum('bhqd,bhnd->bhqn', qc, k_mean).astype(jnp.float32)
        gate = jnp.where(blk_ids < own, gate, -jnp.inf)
        _, sel = lax.top_k(gate, n_sel)
        sel_valid = jnp.arange(n_sel) < own
        k_sel = gather(k_blocks, sel)
        v_sel = gather(v_blocks, sel)
        k_own = lax.dynamic_slice_in_dim(k_blocks, own, 1, axis=2)[:, :, 0]
        v_own = lax.dynamic_slice_in_dim(v_blocks, own, 1, axis=2)[:, :, 0]
        s_sel = jnp.einsum('bhqd,bhqnkd->bhqnk', qc, k_sel).astype(jnp.float32) * scale
        s_sel = jnp.where(sel_valid[:, None], s_sel, -jnp.inf)
        s_own = jnp.einsum('bhqd,bhkd->bhqk', qc, k_own).astype(jnp.float32) * scale
        k_pos = own * MOBA_BLOCK + jnp.arange(MOBA_BLOCK)
        s_own = jnp.where(k_pos[None, :] <= q_pos[:, None], s_own, -jnp.inf)
        n_sk = n_sel * MOBA_BLOCK
        scores = jnp.concatenate([s_sel.reshape(b, h, Q_CHUNK, n_sk), s_own], axis=-1)
        p = jax.nn.softmax(scores, axis=-1)
        p_sel = p[..., :n_sk].reshape(b, h, Q_CHUNK, n_sel, MOBA_BLOCK).astype(v.dtype)
        p_own = p[..., n_sk:].astype(v.dtype)
        return (jnp.einsum('bhqnk,bhqnkd->bhqd', p_sel, v_sel)
                + jnp.einsum('bhqk,bhkd->bhqd', p_own, v_own))

    outs = lax.map(chunk, jnp.arange(s // Q_CHUNK))
    return outs.transpose(1, 2, 0, 3, 4).reshape(b, h, s, dh)


def rg_lru(x, w_a, b_a, w_x, b_x, lam):
    b, s, w = x.shape
    xh = x.reshape(b, s, LRU_HEADS, LRU_HEAD_DIM)
    r = jax.nn.sigmoid(jnp.einsum('bshi,hij->bshj', xh, w_a).reshape(b, s, w) + b_a)
    i = jax.nn.sigmoid(jnp.einsum('bshi,hij->bshj', xh, w_x).reshape(b, s, w) + b_x)
    log_a = -LRU_C * r.astype(jnp.float32) * jax.nn.softplus(-lam.astype(jnp.float32))
    a = jnp.exp(log_a)
    u = jnp.sqrt(-jnp.expm1(2.0 * log_a)) * (i * x).astype(jnp.float32)

    def combine(c1, c2):
        a1, b1 = c1
        a2, b2 = c2
        return a1 * a2, a2 * b1 + b2

    _, hs = lax.associative_scan(combine, (a, u), axis=1)
    return hs.astype(x.dtype)


def hybrid_mixer(x, w_in, lru_conv_w, lru_conv_b, lru_w_a, lru_b_a, lru_w_x, lru_b_x,
                 lru_lambda, sc_conv_w, group_gain, w_out):
    b, s, _ = x.shape
    proj = x @ w_in
    q, k, v, g_att, x_lru, g_lru, sc_b, sc_c, sc_x, g_sc = jnp.split(proj, N_IN_SPLITS, axis=-1)
    heads = lambda t: t.reshape(b, s, ATT_HEADS, ATT_HEAD_DIM).transpose(0, 2, 1, 3)
    y_att = moba_attention(heads(q), heads(k), heads(v)).transpose(0, 2, 1, 3).reshape(b, s, GROUP_WIDTH)
    xl = causal_dwconv(x_lru, lru_conv_w) + lru_conv_b
    y_lru = rg_lru(xl, lru_w_a, lru_b_a, lru_w_x, lru_b_x, lru_lambda)
    y_sc = sc_b * causal_dwconv(sc_c * sc_x, sc_conv_w)
    y = jnp.stack([y_att, y_lru, y_sc], axis=2)
    gates = jnp.stack([g_att, g_lru, g_sc], axis=2)
    y = group_rms_norm(y, group_gain) * jax.nn.silu(gates)
    return y.reshape(b, s, MIX_WIDTH) @ w_out


def memory_cross_attention(x, mem, wq, wk, wv, wo):
    b, s, _ = x.shape
    m = mem.shape[1]
    q = (x @ wq).reshape(b, s, XATTN_HEADS, XATTN_HEAD_DIM)
    k = (mem @ wk).reshape(b, m, XATTN_HEADS, XATTN_HEAD_DIM)
    v = (mem @ wv).reshape(b, m, XATTN_HEADS, XATTN_HEAD_DIM)
    scores = jnp.einsum('bshd,bmhd->bhsm', q, k).astype(jnp.float32) * (XATTN_HEAD_DIM ** -0.5)
    p = jax.nn.softmax(scores, axis=-1).astype(v.dtype)
    o = jnp.einsum('bhsm,bmhd->bshd', p, v).reshape(b, s, D_MODEL)
    return o @ wo


def setup_inputs(seed: int = 0) -> dict:
    key = jax.random.key(seed)
    ks = jax.random.split(key, 24)
    f32 = jnp.float32
    nrm = lambda k, shape, scale: jax.random.normal(k, shape, f32) * scale
    L = DEPTH
    G = GROUP_WIDTH
    u = jax.random.uniform(ks[9], (L, G), f32, 0.9, 0.999)
    p = u ** (1.0 / LRU_C)
    return {
        'x': nrm(ks[0], (BATCH, SEQ, D_MODEL), 1.0),
        'mem': nrm(ks[1], (BATCH, N_MEM, D_MODEL), 1.0),
        'w_in': nrm(ks[2], (L, D_MODEL, IN_COLS), D_MODEL ** -0.5),
        'lru_conv_w': nrm(ks[3], (L, LRU_CONV, G), LRU_CONV ** -0.5),
        'lru_conv_b': nrm(ks[4], (L, G), 0.02),
        'lru_w_a': nrm(ks[5], (L, LRU_HEADS, LRU_HEAD_DIM, LRU_HEAD_DIM), LRU_HEAD_DIM ** -0.5),
        'lru_b_a': nrm(ks[6], (L, G), 0.02),
        'lru_w_x': nrm(ks[7], (L, LRU_HEADS, LRU_HEAD_DIM, LRU_HEAD_DIM), LRU_HEAD_DIM ** -0.5),
        'lru_b_x': nrm(ks[8], (L, G), 0.02),
        'lru_lambda': jnp.log(p) - jnp.log1p(-p),
        'sc_conv_w': nrm(ks[10], (L, SC_CONV, G), SC_CONV ** -0.5),
        'group_gain': 1.0 + nrm(ks[11], (L, N_GROUPS, G), 0.02),
        'w_out': nrm(ks[12], (L, MIX_WIDTH, D_MODEL), MIX_WIDTH ** -0.5 * DN_BETA),
        'ln1_g': 1.0 + nrm(ks[13], (L, D_MODEL), 0.02),
        'ln1_b': nrm(ks[14], (L, D_MODEL), 0.02),
        'xq_w': nrm(ks[15], (L, D_MODEL, D_MODEL), D_MODEL ** -0.5),
        'xk_w': nrm(ks[16], (L, D_MODEL, D_MODEL), D_MODEL ** -0.5),
        'xv_w': nrm(ks[17], (L, D_MODEL, D_MODEL), D_MODEL ** -0.5),
        'xo_w': nrm(ks[18], (L, D_MODEL, D_MODEL), D_MODEL ** -0.5 * DN_BETA),
        'ln2_g': 1.0 + nrm(ks[19], (L, D_MODEL), 0.02),
        'ln2_b': nrm(ks[20], (L, D_MODEL), 0.02),
    }


def reference(x, mem, w_in, lru_conv_w, lru_conv_b, lru_w_a, lru_b_a, lru_w_x, lru_b_x,
              lru_lambda, sc_conv_w, group_gain, w_out, ln1_g, ln1_b,
              xq_w, xk_w, xv_w, xo_w, ln2_g, ln2_b):
    for l in range(DEPTH):
        mix = hybrid_mixer(x, w_in[l], lru_conv_w[l], lru_conv_b[l], lru_w_a[l], lru_b_a[l],
                           lru_w_x[l], lru_b_x[l], lru_lambda[l], sc_conv_w[l], group_gain[l], w_out[l])
        x = layer_norm(DN_ALPHA * x + mix, ln1_g[l], ln1_b[l])
        xat = memory_cross_attention(x, mem, xq_w[l], xk_w[l], xv_w[l], xo_w[l])
        x = layer_norm(DN_ALPHA * x + xat, ln2_g[l], ln2_b[l])
    return x
```

```cpp
#include <hip/hip_runtime.h>
#include <cstdio>
#include <cstdint>
#include <cmath>

#define LAS __attribute__((address_space(3)))
#define GAS __attribute__((address_space(1)))
typedef unsigned short bf16;
typedef short bf16x8 __attribute__((ext_vector_type(8)));
typedef float f32x4 __attribute__((ext_vector_type(4)));
typedef float f32x2 __attribute__((ext_vector_type(2)));
typedef unsigned u32x4 __attribute__((ext_vector_type(4)));
typedef unsigned u32x2 __attribute__((ext_vector_type(2)));

constexpr int BATCH = 4, SEQ = 8192, DM = 1024, T = BATCH * SEQ, DEPTH = 2, NMEM = 256;
constexpr int GW = 512, MIXW = 1536, INC = 5120, NH = 8, HD = 64, MBLK = 256, NBLK = SEQ / MBLK;
constexpr int C_Q = 0, C_K = 512, C_V = 1024, C_GATT = 1536, C_XLRU = 2048, C_GLRU = 2560, C_SCB = 3072, C_SCC = 3584, C_SCX = 4096, C_GSC = 4608;
constexpr float DN_ALPHA = 1.41421356237309515f;
constexpr float LN_EPS = 1e-5f, RMS_EPS = 1e-6f;
constexpr float LOG2E = 1.4426950408889634f;
constexpr float C2_ATT = 0.125f * LOG2E;
constexpr float C2_X = 0.0625f * LOG2E;
constexpr int LRU_TILE = 128, LRU_NT = SEQ / LRU_TILE;

constexpr size_t MiB = 1u << 20;
constexpr size_t WS_CTL = 0, CTL_ZERO_BYTES = 1 * MiB;
constexpr size_t WS_W = 2 * MiB, W_LAYER = 21 * MiB;
constexpr size_t WO_IN = 0, WO_OUT = 10 * MiB, WO_Q = 13 * MiB, WO_K = 15 * MiB, WO_V = 17 * MiB, WO_O = 19 * MiB;
constexpr size_t WS_MEMB = 44 * MiB, WS_KMEM = 46 * MiB, WS_VMT = 50 * MiB, WS_KMEAN = 54 * MiB, WS_LRUS = 55 * MiB;
constexpr size_t WS_XB = 64 * MiB, WS_PROJ = 128 * MiB;
constexpr size_t WS_Q2 = 128 * MiB, WS_S = 192 * MiB, WS_P = 320 * MiB, WS_O2 = 384 * MiB, WS_END = 448 * MiB;
constexpr int CW_BAR = 4096;

__device__ __forceinline__ float bf2f(unsigned h) { return __uint_as_float(h << 16); }
__device__ __forceinline__ unsigned f2bf(float f) { unsigned u = __float_as_uint(f); return (u + 0x7fffu + ((u >> 16) & 1u)) >> 16; }
__device__ __forceinline__ unsigned pk2(float lo, float hi) { return f2bf(lo) | (f2bf(hi) << 16); }
__device__ __forceinline__ void unpack8(const u32x4 w, float* f) {
    f[0] = __uint_as_float(w.x << 16); f[1] = __uint_as_float(w.x & 0xffff0000u); f[2] = __uint_as_float(w.y << 16); f[3] = __uint_as_float(w.y & 0xffff0000u);
    f[4] = __uint_as_float(w.z << 16); f[5] = __uint_as_float(w.z & 0xffff0000u); f[6] = __uint_as_float(w.w << 16); f[7] = __uint_as_float(w.w & 0xffff0000u);
}
__device__ __forceinline__ u32x4 pack8(const float* f) { u32x4 w; w.x = pk2(f[0], f[1]); w.y = pk2(f[2], f[3]); w.z = pk2(f[4], f[5]); w.w = pk2(f[6], f[7]); return w; }
__device__ __forceinline__ float wave_sum(float v) {
#pragma unroll
    for (int o = 1; o < 64; o <<= 1) v += __shfl_xor(v, o);
    return v;
}
__device__ __forceinline__ float wave_max(float v) {
#pragma unroll
    for (int o = 1; o < 64; o <<= 1) v = fmaxf(v, __shfl_xor(v, o));
    return v;
}
__device__ __forceinline__ float sigmoidf_(float x) { return 1.f / (1.f + __expf(-x)); }
template <class Tp> __device__ __forceinline__ Tp* opq(Tp* p) { asm volatile("" : "+s"(p)); return p; }
__device__ __forceinline__ int opq_v(int v) { asm volatile("" : "+v"(v)); return v; }
__device__ __forceinline__ int opq_s(int v) { asm volatile("" : "+s"(v)); return v; }
#define PHASE_IDS() const int tid = opq_v(F.tid); const int lane = tid & 63; const int wave = opq_s(F.wave); const int vcu = opq_s(F.vcu); (void)tid; (void)lane; (void)wave; (void)vcu
#define LDS_WAIT() asm volatile("s_waitcnt lgkmcnt(0)" ::: "memory")
#define VM_WAIT() asm volatile("s_waitcnt vmcnt(0)" ::: "memory")

namespace pg8 {
constexpr int BM = 256, BK = 64, HALF = 128, HTB = HALF * BK * 2, STAGE_BYTES = 8 * HTB, NXCD = 8, WGM = 8;
__host__ __device__ __forceinline__ int lds_byte(int r, int c) { const int st = (r >> 4) * 2 + (c >> 5), rr = r & 15, cc = c & 31, ob = rr * 64 + cc * 2; return st * 1024 + (ob ^ (((ob >> 9) & 1) << 5)); }
__host__ __device__ __forceinline__ void stage_rc(int b, int& R, int& C) { const int st = b / 1024, sb = b % 1024, swz = sb ^ (((sb >> 9) & 1) << 5); R = (st >> 1) * 16 + swz / 64; C = (st & 1) * 32 + (swz % 64) / 2; }
__host__ __device__ __forceinline__ int perm32(int rho) { const int n = rho >> 4, i = rho & 15; return 8 * (i >> 2) + 4 * n + (i & 3); }

struct Unit { int pm, pn; };
struct Gemm {
    const bf16* A; const bf16* Bt; int lda, ldb, K; size_t a_pm, a_pn, b_pn, b_pb;
    __device__ __forceinline__ const char* aptr(const Unit& u) const { return (const char*)(A + (size_t)u.pm * a_pm + (size_t)u.pn * a_pn); }
    __device__ __forceinline__ const char* bptr(const Unit& u) const { return (const char*)(Bt + (size_t)u.pn * b_pn + (size_t)(u.pm >> 5) * b_pb); }
};
__device__ __forceinline__ Gemm gemm_plain(const bf16* A, int lda, const bf16* Bt, int ldb, int K) { Gemm g; g.A = opq(A); g.Bt = opq(Bt); g.lda = lda; g.ldb = ldb; g.K = K; g.a_pm = (size_t)256 * lda; g.a_pn = 0; g.b_pn = (size_t)256 * ldb; g.b_pb = 0; return g; }

struct StaticOrder {
    int nM, nN, nwg, G, c;
    __host__ __device__ void init(int M, int N, int G_, int c_) { nM = M / BM; nN = N / BM; nwg = nM * nN; G = G_; c = c_; }
    __host__ __device__ bool next(int i, Unit& u) const {
        const long L = (long)i * G + c; if (L >= nwg) return false;
        int wgid = (int)L; { const int q = nwg / NXCD, r = nwg % NXCD, xcd = wgid % NXCD, off = wgid / NXCD; wgid = (xcd < r ? xcd * (q + 1) : r * (q + 1) + (xcd - r) * q) + off; }
        const int nig = WGM * nN, gid = wgid / nig, fm = gid * WGM, gsz = (nM - fm) < WGM ? (nM - fm) : WGM;
        u.pm = fm + ((wgid % nig) % gsz); u.pn = (wgid % nig) / gsz; return true;
    }
};

__device__ __forceinline__ unsigned cvt_pk_bf16(float lo, float hi) { unsigned r; asm volatile("v_cvt_pk_bf16_f32 %0, %1, %2" : "=v"(r) : "v"(lo), "v"(hi)); return r; }

struct EpiBf16 {
    static constexpr bool PERM = true;
    bf16* O; int ldc; float scale_lo; int ncols_lo;
    __device__ __forceinline__ void operator()(const f32x4 (&acc)[2][2][4][2], const Unit& u, int wr, int wc, int fr, int fq) const {
        const int row0 = u.pm * BM + wr * 64 + fr, col0 = u.pn * BM + wc * 32 + 8 * fq;
        const float sc = (u.pn * BM < ncols_lo) ? scale_lo : 1.f;
#pragma unroll
        for (int ai = 0; ai < 2; ++ai)
#pragma unroll
            for (int m = 0; m < 4; ++m) { bf16* rowp = O + (size_t)(row0 + ai * HALF + m * 16) * ldc + col0;
#pragma unroll
                for (int bj = 0; bj < 2; ++bj) { const f32x4 v0 = acc[ai][bj][m][0] * sc, v1 = acc[ai][bj][m][1] * sc;
                    u32x4 w; w.x = cvt_pk_bf16(v0[0], v0[1]); w.y = cvt_pk_bf16(v0[2], v0[3]); w.z = cvt_pk_bf16(v1[0], v1[1]); w.w = cvt_pk_bf16(v1[2], v1[3]);
                    *(u32x4*)(rowp + bj * HALF) = w; } }
    }
};
struct EpiF32Res {
    static constexpr bool PERM = false;
    const float* base; float* out; int ldc; float alpha;
    __device__ __forceinline__ void operator()(const f32x4 (&acc)[2][2][4][2], const Unit& u, int wr, int wc, int fr, int fq) const {
        const int row0 = u.pm * BM + wr * 64 + fr, col0 = u.pn * BM + wc * 32 + 4 * fq;
#pragma unroll
        for (int ai = 0; ai < 2; ++ai)
#pragma unroll
            for (int m = 0; m < 4; ++m) { const size_t off = (size_t)(row0 + ai * HALF + m * 16) * ldc + col0;
#pragma unroll
                for (int bj = 0; bj < 2; ++bj)
#pragma unroll
                    for (int n = 0; n < 2; ++n) { f32x4 v = acc[ai][bj][m][n];
                        if (base) { const f32x4 bs = *(const f32x4*)(base + off + bj * HALF + n * 16); v = v + bs * alpha; }
                        *(f32x4*)(out + off + bj * HALF + n * 16) = v; } }
    }
};

template <class Epi, class Sched, bool ALIGN_EPI>
__device__ __forceinline__ void gemm_phase(LAS unsigned char* lds, const Gemm g, const Sched& S, const Epi& E) {
    const int tid = opq_v((int)threadIdx.x), wid = __builtin_amdgcn_readfirstlane(tid >> 6), lane = tid & 63, wr = wid >> 2, wc = wid & 3, fr = lane & 15, fq = lane >> 4;
    const int K = g.K, nt = K / BK;
    unsigned voffA[2], voffB[2];
#pragma unroll
    for (int i = 0; i < 2; ++i) { int R, C; stage_rc(tid * 16 + i * 8192, R, C); const int Rb = Epi::PERM ? ((R & ~31) + perm32(R & 31)) : R;
        voffA[i] = (unsigned)(R * g.lda + C) * 2u; voffB[i] = (unsigned)(Rb * g.ldb + C) * 2u; }
    const size_t kstep = (size_t)(BK * 2);
    const size_t hstepA = (size_t)HALF * g.lda * 2, hstepB = (size_t)HALF * g.ldb * 2;
    const unsigned ldsw = (unsigned)wid * 1024u;
    const int aoff = lds_byte(wr * 64 + fr, fq * 8), boff = lds_byte(wc * 32 + fr, fq * 8);
#define PG8_SA(b, h) (((b) * 2 + (h)) * HTB)
#define PG8_SB(b, h) ((4 + (b) * 2 + (h)) * HTB)
#define PG8_STAGE(bufoff, gbase, voff) do { _Pragma("unroll") for (int _i = 0; _i < 2; ++_i) \
        __builtin_amdgcn_global_load_lds((const unsigned*)((const char*)(gbase) + (voff)[_i]), (LAS unsigned*)(lds + (bufoff) + ldsw + _i * 8192), 16, 0, 0); } while (0)
#define PG8_LDA(dst, b, h) do { _Pragma("unroll") for (int m = 0; m < 4; ++m) _Pragma("unroll") for (int k = 0; k < 2; ++k) dst[m][k] = *(const LAS bf16x8*)(lds + PG8_SA(b, h) + aoff + m * 2048 + k * 1024); } while (0)
#define PG8_LDB(dst, b, h) do { _Pragma("unroll") for (int n = 0; n < 2; ++n) _Pragma("unroll") for (int k = 0; k < 2; ++k) dst[n][k] = *(const LAS bf16x8*)(lds + PG8_SB(b, h) + boff + n * 2048 + k * 1024); } while (0)
#define PG8_MMA(ai, bj, At, Bt) do { __builtin_amdgcn_s_setprio(1); _Pragma("unroll") for (int m = 0; m < 4; ++m) _Pragma("unroll") for (int n = 0; n < 2; ++n) _Pragma("unroll") for (int k = 0; k < 2; ++k) \
        acc[ai][bj][m][n] = __builtin_amdgcn_mfma_f32_16x16x32_bf16(Bt[n][k], At[m][k], acc[ai][bj][m][n], 0, 0, 0); __builtin_amdgcn_s_setprio(0); } while (0)
#define PG8_WAIT_V(n) asm volatile("s_waitcnt vmcnt(" #n ")" ::: "memory")
#define PG8_WAIT_L(n) asm volatile("s_waitcnt lgkmcnt(" #n ")" ::: "memory")
#define PG8_BAR __builtin_amdgcn_s_barrier()
#define PG8_SCHED __builtin_amdgcn_sched_barrier(0)
    Unit cur, nxt; int ui = 0;
    if (!S.next(0, cur)) return;
    f32x4 acc[2][2][4][2];
#pragma unroll
    for (int a = 0; a < 2; ++a)
#pragma unroll
        for (int b = 0; b < 2; ++b)
#pragma unroll
            for (int m = 0; m < 4; ++m)
#pragma unroll
                for (int n = 0; n < 2; ++n) acc[a][b][m][n] = (f32x4){0.f, 0.f, 0.f, 0.f};
    bf16x8 At[4][2], B0[2][2], B1[2][2];
    const char* cA = g.aptr(cur); const char* cB = g.bptr(cur);
    PG8_STAGE(PG8_SB(0, 0), cB, voffB); PG8_STAGE(PG8_SB(0, 1), cB + hstepB, voffB); PG8_STAGE(PG8_SA(0, 0), cA, voffA); PG8_STAGE(PG8_SA(0, 1), cA + hstepA, voffA);
    if (wr == 1) PG8_BAR;
    PG8_WAIT_V(2); PG8_BAR;
    PG8_STAGE(PG8_SB(1, 0), cB + kstep, voffB); PG8_STAGE(PG8_SA(1, 0), cA + kstep, voffA); PG8_STAGE(PG8_SB(1, 1), cB + hstepB + kstep, voffB);
    PG8_WAIT_V(6); PG8_BAR;
    for (;;) {
        const bool has_next = S.next(ui + 1, nxt);
        const char* nA = has_next ? g.aptr(nxt) : cA; const char* nB = has_next ? g.bptr(nxt) : cB;
        for (int t = 0; t < nt; t += 2) {
            const bool last = (t == nt - 2);
            const char* a1 = cA + (size_t)(t + 1) * kstep;
            const char* a2 = last ? nA : cA + (size_t)(t + 2) * kstep; const char* b2 = last ? nB : cB + (size_t)(t + 2) * kstep;
            const char* a3 = a2 + kstep; const char* b3 = b2 + kstep;
            PG8_LDB(B0, 0, 0); PG8_LDB(B1, 0, 1); PG8_SCHED; PG8_LDA(At, 0, 0); PG8_STAGE(PG8_SA(1, 1), a1 + hstepA, voffA);
            PG8_WAIT_V(8); PG8_WAIT_L(0); PG8_BAR; PG8_MMA(0, 0, At, B0); PG8_MMA(0, 1, At, B1); PG8_BAR; PG8_SCHED;
            PG8_LDA(At, 0, 1); PG8_STAGE(PG8_SB(0, 0), b2, voffB); PG8_STAGE(PG8_SB(0, 1), b2 + hstepB, voffB); PG8_STAGE(PG8_SA(0, 0), a2, voffA);
            PG8_WAIT_V(8); PG8_WAIT_L(0); PG8_BAR; PG8_MMA(1, 0, At, B0); PG8_MMA(1, 1, At, B1); PG8_BAR; PG8_SCHED;
            PG8_LDB(B0, 1, 0); PG8_LDB(B1, 1, 1); PG8_SCHED; PG8_LDA(At, 1, 0); PG8_STAGE(PG8_SA(0, 1), a2 + hstepA, voffA);
            PG8_WAIT_V(8); PG8_WAIT_L(0); PG8_BAR; PG8_MMA(0, 0, At, B0); PG8_MMA(0, 1, At, B1); PG8_BAR; PG8_SCHED;
            PG8_LDA(At, 1, 1); PG8_STAGE(PG8_SB(1, 0), b3, voffB); PG8_STAGE(PG8_SB(1, 1), b3 + hstepB, voffB); PG8_STAGE(PG8_SA(1, 0), a3, voffA);
            PG8_WAIT_V(8); PG8_WAIT_L(0); PG8_BAR; PG8_MMA(1, 0, At, B0); PG8_MMA(1, 1, At, B1); PG8_BAR; PG8_SCHED;
        }
        if constexpr (ALIGN_EPI) { if (wr == 0) PG8_BAR; }
        E(acc, cur, wr, wc, fr, fq);
        if (!has_next) break;
#pragma unroll
        for (int a = 0; a < 2; ++a)
#pragma unroll
            for (int b = 0; b < 2; ++b)
#pragma unroll
                for (int m = 0; m < 4; ++m)
#pragma unroll
                    for (int n = 0; n < 2; ++n) acc[a][b][m][n] = (f32x4){0.f, 0.f, 0.f, 0.f};
        cur = nxt; cA = nA; cB = nB; ++ui;
        if constexpr (ALIGN_EPI) { if (wr == 1) PG8_BAR; }
    }
    PG8_WAIT_V(0);
    if constexpr (!ALIGN_EPI) { if (wr == 0) PG8_BAR; }
    PG8_BAR;
#undef PG8_SA
#undef PG8_SB
#undef PG8_STAGE
#undef PG8_LDA
#undef PG8_LDB
#undef PG8_MMA
#undef PG8_WAIT_V
#undef PG8_WAIT_L
#undef PG8_BAR
#undef PG8_SCHED
}
}

constexpr int NWAVES = 8;
constexpr int RING_OFF = 0, RING_BYTES = 131072;
constexpr int LDSCTL_OFF = RING_BYTES, MISC_OFF = LDSCTL_OFF + 320;
constexpr int LDS_BYTES = 147456;

typedef GAS unsigned gu32;
#define RLX_AGENT __ATOMIC_RELAXED, __HIP_MEMORY_SCOPE_AGENT
#define XB_TMO      128
#define XB_XCNT(j)  (256  + 64 * (j))
#define XB_XSUB(j)  (1280 + 64 * (j))
#define XB_XGEN(j)  (2304 + 64 * (j))
#define XB_TOP      3328
#define XB_TOPGEN   3392
#define XCD_BAR_WORDS 3456
#define XB_SPIN_CAP (1u << 18)
__device__ __forceinline__ unsigned xb_ld(unsigned* p)              { return __hip_atomic_load(p, __ATOMIC_RELAXED, __HIP_MEMORY_SCOPE_AGENT); }
__device__ __forceinline__ unsigned xb_add(unsigned* p, unsigned v) { return __hip_atomic_fetch_add(p, v, __ATOMIC_RELAXED, __HIP_MEMORY_SCOPE_AGENT); }
__device__ __forceinline__ unsigned xb_xcc_id() { return (unsigned)__builtin_amdgcn_s_getreg((3 << 11) | 20) & 0xFu; }
#define XB_SPIN(cond, bar) do { unsigned _sp = 0; while (cond) { __builtin_amdgcn_s_sleep(1); \
    if ((++_sp & 255u) == 0u) { if (xb_ld(&(bar)[XB_TMO])) break; if (_sp > XB_SPIN_CAP) { atomicAdd(&(bar)[XB_TMO], 1u); break; } } } } while (0)
struct XcdBarrier { unsigned* bar; unsigned x; volatile LAS unsigned* st; };
__device__ __forceinline__ XcdBarrier xcd_barrier_post(unsigned* bar, volatile LAS unsigned* st) {
    XcdBarrier b; b.bar = bar; b.x = xb_xcc_id(); b.st = st;
    if (threadIdx.x == 0) (void)xb_add(&bar[XB_XCNT(b.x)], 1u);
    return b;
}
__device__ __forceinline__ void xcd_barrier_complete(unsigned* bar, unsigned x, unsigned& nloc, unsigned& nx) {
    const unsigned G = gridDim.x * gridDim.y * gridDim.z;
    unsigned sum, cnt, mine, sp = 0u;
    for (;;) {
        sum = 0u; cnt = 0u; mine = 0u;
#pragma unroll
        for (unsigned j = 0; j < 16; ++j) { const unsigned c = xb_ld(&bar[XB_XCNT(j)]); sum += c; cnt += (c > 0u) ? 1u : 0u; mine = (j == x) ? c : mine; }
        if (sum == G) break;
        __builtin_amdgcn_s_sleep(1);
        if ((++sp & 255u) == 0u) { if (xb_ld(&bar[XB_TMO])) break; if (sp > XB_SPIN_CAP) { atomicAdd(&bar[XB_TMO], 1u); break; } }
    }
    nloc = mine > 0u ? mine : 1u; nx = cnt > 0u ? cnt : 1u;
}
__device__ __forceinline__ void xcd_barrier_census(const XcdBarrier& b) {
    if (threadIdx.x == 0) { unsigned nloc, nx; xcd_barrier_complete(b.bar, b.x, nloc, nx); b.st[0] = nloc; b.st[1] = nx; }
}
__device__ __forceinline__ void xcd_barrier(const XcdBarrier& b) {
    asm volatile("s_waitcnt vmcnt(0)" ::: "memory");
    __syncthreads();
    if (threadIdx.x == 0) {
        unsigned* bar = b.bar;
        __builtin_amdgcn_s_waitcnt(0);
        const unsigned nloc = b.st[0], nx = b.st[1];
        const unsigned old = xb_add(&bar[XB_XSUB(b.x)], 1u);
        const unsigned gen = old / nloc;
        if (old + 1u == (gen + 1u) * nloc) {
            __builtin_amdgcn_fence(__ATOMIC_RELEASE, "agent");
            asm volatile("s_waitcnt vmcnt(0)" ::: "memory");
            const unsigned og = xb_add(&bar[XB_TOP], 1u);
            const unsigned tg = og / nx;
            if (og + 1u == (tg + 1u) * nx) xb_add(&bar[XB_TOPGEN], 1u);
            else XB_SPIN(xb_ld(&bar[XB_TOPGEN]) == tg, bar);
            __builtin_amdgcn_fence(__ATOMIC_ACQUIRE, "agent");
            xb_add(&bar[XB_XGEN(b.x)], 1u);
            asm volatile("s_waitcnt vmcnt(0)" ::: "memory");
        } else {
            XB_SPIN(xb_ld(&bar[XB_XGEN(b.x)]) == gen, bar);
            __builtin_amdgcn_fence(__ATOMIC_ACQUIRE, "agent");
            asm volatile("s_waitcnt vmcnt(0)" ::: "memory");
        }
    }
    __syncthreads();
}

struct Frame {
    LAS unsigned char* lds;
    int tid, lane, wave;
    int vcu, G;
};

__device__ __forceinline__ void p0_transpose_item(const float* W, int K, int N, bf16* WT, LAS float* scr, int item, int lane) {
    const int nblk = N / 32, kb = item / nblk, nb = item % nblk, k0 = 64 * kb, n0 = 32 * nb;
#pragma unroll 8
    for (int i = 0; i < 32; ++i) { const int kk = 2 * i + (lane >> 5); scr[kk * 33 + (lane & 31)] = W[(size_t)(k0 + kk) * N + n0 + (lane & 31)]; }
    LDS_WAIT(); asm volatile("" ::: "memory");
    const int c = lane & 7;
#pragma unroll
    for (int j = 0; j < 4; ++j) { const int n = (lane >> 3) + 8 * j; const LAS float* s = scr + (8 * c) * 33 + n;
        u32x4 o; o.x = pk2(s[0 * 33], s[1 * 33]); o.y = pk2(s[2 * 33], s[3 * 33]); o.z = pk2(s[4 * 33], s[5 * 33]); o.w = pk2(s[6 * 33], s[7 * 33]);
        *(GAS u32x4*)(WT + (size_t)(n0 + n) * K + k0 + 8 * c) = o; }
    LDS_WAIT(); asm volatile("" ::: "memory");
}
__device__ __forceinline__ void row_to_bf16(const float* xrow, bf16* orow, int lane) {
    const GAS f32x4* xr = (const GAS f32x4*)xrow + lane;
    GAS u32x2* o8 = (GAS u32x2*)orow + lane;
#pragma unroll
    for (int j = 0; j < 4; ++j) { const f32x4 v = xr[64 * j]; u32x2 w; w.x = pk2(v.x, v.y); w.y = pk2(v.z, v.w); o8[64 * j] = w; }
}

struct Args { const float* in[21]; float* out; unsigned char* ws; int ph_lo, ph_hi; };

__device__ __forceinline__ void p0_prologue(Frame& F, const Args& a) {
    PHASE_IDS();
    LAS float* scr = (LAS float*)(F.lds + RING_OFF + wave * 16384);
    const int gw = vcu * NWAVES + wave, NGW = F.G * NWAVES;
    constexpr int I_IN = (DM / 64) * (INC / 32), I_OUT = (MIXW / 64) * (DM / 32), I_SQ = (DM / 64) * (DM / 32);
    constexpr int I_LAYER = I_IN + I_OUT + 4 * I_SQ;
    for (int it = gw; it < DEPTH * I_LAYER; it += NGW) {
        const int l = it / I_LAYER; int r = it % I_LAYER;
        unsigned char* wl = a.ws + WS_W + (size_t)l * W_LAYER;
        const float* W; int K = DM, N = DM; bf16* WT;
        if (r < I_IN) { W = a.in[2] + (size_t)l * DM * INC; N = INC; WT = (bf16*)(wl + WO_IN); }
        else if ((r -= I_IN) < I_OUT) { W = a.in[12] + (size_t)l * MIXW * DM; K = MIXW; WT = (bf16*)(wl + WO_OUT); }
        else { r -= I_OUT; const int which = r / I_SQ; r -= which * I_SQ;
               const float* base = which == 0 ? a.in[15] : (which == 1 ? a.in[16] : (which == 2 ? a.in[17] : a.in[18]));
               W = base + (size_t)l * DM * DM; WT = (bf16*)(wl + WO_Q + (size_t)which * 2 * MiB); }
        p0_transpose_item(W, K, N, WT, scr, r, lane);
    }
    bf16* XB = (bf16*)(a.ws + WS_XB); bf16* MEMB = (bf16*)(a.ws + WS_MEMB);
    for (int m = gw; m < T; m += NGW) row_to_bf16(a.in[0] + (size_t)m * DM, XB + (size_t)m * DM, lane);
    for (int m = gw; m < BATCH * NMEM; m += NGW) row_to_bf16(a.in[1] + (size_t)m * DM, MEMB + (size_t)m * DM, lane);
}

__device__ __forceinline__ void kmean_phase(Frame& F, const bf16* PROJ, float* kmean) {
    PHASE_IDS();
    const int gw = vcu * NWAVES + wave, NGW = F.G * NWAVES;
    const int dg = lane & 7, rg = lane >> 3;
    for (int it = gw; it < BATCH * NH * NBLK; it += NGW) {
        const int bh = it >> 5, blk = it & 31, b = bh >> 3, h = bh & 7;
        const bf16* kp = PROJ + ((size_t)(b * SEQ + blk * MBLK + rg)) * INC + C_K + h * HD + dg * 8;
        float acc[8];
#pragma unroll
        for (int e = 0; e < 8; ++e) acc[e] = 0.f;
        for (int i = 0; i < 32; ++i) { const u32x4 w = *(const GAS u32x4*)(kp + (size_t)(8 * i) * INC); float f[8]; unpack8(w, f);
#pragma unroll
            for (int e = 0; e < 8; ++e) acc[e] += f[e]; }
#pragma unroll
        for (int e = 0; e < 8; ++e) { float v = acc[e]; v += __shfl_xor(v, 8); v += __shfl_xor(v, 16); v += __shfl_xor(v, 32); acc[e] = v * (1.f / 256.f); }
        if (rg == 0) { float* o = kmean + (size_t)it * HD + dg * 8;
            *(f32x4*)o = (f32x4){acc[0], acc[1], acc[2], acc[3]}; *(f32x4*)(o + 4) = (f32x4){acc[4], acc[5], acc[6], acc[7]}; }
    }
}

__device__ __forceinline__ void moba_naive_phase(Frame& F, bf16* PROJ, const float* kmean) {
    PHASE_IDS();
    const int gtid = vcu * (NWAVES * 64) + tid, NTH = F.G * NWAVES * 64;
    for (int item = gtid; item < BATCH * NH * SEQ; item += NTH) {
        const int bh = item >> 13, q = item & (SEQ - 1), b = bh >> 3, h = bh & 7, own = q >> 8;
        bf16* qrow = PROJ + ((size_t)(b * SEQ + q)) * INC + C_Q + h * HD;
        float qv[64];
#pragma unroll
        for (int c = 0; c < 8; ++c) unpack8(*(const GAS u32x4*)(qrow + 8 * c), qv + 8 * c);
        float g0 = -3e38f, g1 = -3e38f, g2 = -3e38f; int i0 = 0, i1 = 0, i2 = 0;
        const float* km = kmean + (size_t)bh * NBLK * HD;
        for (int j = 0; j < own; ++j) {
            float s = 0.f;
#pragma unroll
            for (int c = 0; c < 16; ++c) { const f32x4 kv = *(const GAS f32x4*)(km + j * HD + 4 * c); s += qv[4 * c] * kv.x + qv[4 * c + 1] * kv.y + qv[4 * c + 2] * kv.z + qv[4 * c + 3] * kv.w; }
            if (s > g0) { g2 = g1; i2 = i1; g1 = g0; i1 = i0; g0 = s; i0 = j; }
            else if (s > g1) { g2 = g1; i2 = i1; g1 = s; i1 = j; }
            else if (s > g2) { g2 = s; i2 = j; }
        }
        const int nsel = own < 3 ? own : 3;
        float m = -1e30f, l = 0.f; float o[64];
#pragma unroll
        for (int d = 0; d < 64; ++d) o[d] = 0.f;
        for (int si = 0; si <= nsel; ++si) {
            int blk, nk;
            if (si < nsel) { blk = (si == 0) ? i0 : ((si == 1) ? i1 : i2); nk = MBLK; } else { blk = own; nk = (q & (MBLK - 1)) + 1; }
            const bf16* kp = PROJ + ((size_t)(b * SEQ + blk * MBLK)) * INC + C_K + h * HD;
            for (int key = 0; key < nk; ++key, kp += INC) {
                float s = 0.f;
#pragma unroll
                for (int c = 0; c < 8; ++c) { float kf[8]; unpack8(*(const GAS u32x4*)(kp + 8 * c), kf);
#pragma unroll
                    for (int e = 0; e < 8; ++e) s += qv[8 * c + e] * kf[e]; }
                if (s > m) { const float f = __builtin_amdgcn_exp2f(m - s); l *= f;
#pragma unroll
                    for (int d = 0; d < 64; ++d) o[d] *= f;
                    m = s; }
                const float p = __builtin_amdgcn_exp2f(s - m); l += p;
                const bf16* vp = kp + (C_V - C_K);
#pragma unroll
                for (int c = 0; c < 8; ++c) { float vf[8]; unpack8(*(const GAS u32x4*)(vp + 8 * c), vf);
#pragma unroll
                    for (int e = 0; e < 8; ++e) o[8 * c + e] += p * vf[e]; }
            }
        }
        const float inv = 1.f / l;
#pragma unroll
        for (int c = 0; c < 8; ++c) { float t8[8];
#pragma unroll
            for (int e = 0; e < 8; ++e) t8[e] = o[8 * c + e] * inv;
            *(GAS u32x4*)(qrow + 8 * c) = pack8(t8); }
    }
}

struct LruParams { const float *conv_w, *conv_b, *w_a, *b_a, *w_x, *b_x, *lam, *sc_w, *gain; };
template <int PASS>
__device__ __forceinline__ void lru_phase(Frame& F, bf16* PROJ, float* lrus, const LruParams& P) {
    PHASE_IDS();
    LAS float* XL = (LAS float*)(F.lds + RING_OFF);
    LAS float* HL = (LAS float*)(F.lds + RING_OFF + 65536);
    const int c = tid, h = wave, j = lane;
    float wa[64], wx[64];
#pragma unroll
    for (int i = 0; i < 64; ++i) { wa[i] = P.w_a[(size_t)(h * 64 + i) * 64 + j]; wx[i] = P.w_x[(size_t)(h * 64 + i) * 64 + j]; }
    const float ba = P.b_a[c], bx = P.b_x[c], cb = P.conv_b[c];
    const float cw0 = P.conv_w[0 * GW + c], cw1 = P.conv_w[1 * GW + c], cw2 = P.conv_w[2 * GW + c], cw3 = P.conv_w[3 * GW + c];
    const float lamv = P.lam[c];
    const float sp8 = 8.0f * log1pf(__expf(-lamv));
    for (int item = blockIdx.x; item < BATCH * LRU_NT; item += F.G) {
        const int b = item / LRU_NT, tile = item % LRU_NT, t0 = tile * LRU_TILE;
        const size_t rowb = (size_t)b * SEQ;
        float hst = 0.f, aprod = 1.f;
        if (PASS == 2) { const f32x2* sp = (const f32x2*)lrus + (size_t)(b * LRU_NT) * GW + c;
            for (int k = 0; k < tile; ++k) { const f32x2 s = sp[(size_t)k * GW]; hst = s.x * hst + s.y; } }
        float xm3 = 0.f, xm2 = 0.f, xm1 = 0.f;
        if (t0 > 0) { const bf16* xp = PROJ + (rowb + t0) * INC + C_XLRU + c;
            xm3 = bf2f(xp[-3 * (long)INC]); xm2 = bf2f(xp[-2 * (long)INC]); xm1 = bf2f(xp[-1 * (long)INC]); }
        for (int st = 0; st < LRU_TILE / 32; ++st) {
            const int ts = t0 + st * 32;
            { const bf16* xp = PROJ + (rowb + ts) * INC + C_XLRU + c;
              for (int tt = 0; tt < 32; ++tt) { const float x0 = bf2f(xp[(size_t)tt * INC]); XL[tt * GW + c] = cw0 * xm3 + cw1 * xm2 + cw2 * xm1 + cw3 * x0 + cb; xm3 = xm2; xm2 = xm1; xm1 = x0; } }
            __syncthreads();
            for (int tt = 0; tt < 32; ++tt) {
                const LAS f32x4* xr = (const LAS f32x4*)(XL + tt * GW + h * 64);
                float ra = ba, ri = bx;
#pragma unroll
                for (int i4 = 0; i4 < 16; ++i4) { const f32x4 xv = xr[i4];
                    ra += xv.x * wa[4 * i4] + xv.y * wa[4 * i4 + 1] + xv.z * wa[4 * i4 + 2] + xv.w * wa[4 * i4 + 3];
                    ri += xv.x * wx[4 * i4] + xv.y * wx[4 * i4 + 1] + xv.z * wx[4 * i4 + 2] + xv.w * wx[4 * i4 + 3]; }
                const float r = sigmoidf_(ra), ig = sigmoidf_(ri);
                const float la = -sp8 * r, av = __expf(la);
                const float u = sqrtf(-expm1f(2.f * la)) * (ig * XL[tt * GW + c]);
                hst = av * hst + u; aprod *= av;
                if (PASS == 2) HL[tt * GW + c] = hst;
            }
            __syncthreads();
            if (PASS == 2) {
                const int c8 = 8 * lane;
                for (int k = 0; k < 4; ++k) {
                    const int tt = wave + 8 * k, t = ts + tt;
                    bf16* prow = PROJ + (rowb + t) * INC;
                    float v[8], gt[8], y[8];
                    unpack8(*(const GAS u32x4*)(prow + C_Q + c8), v); unpack8(*(const GAS u32x4*)(prow + C_GATT + c8), gt);
                    { float ss = 0.f;
#pragma unroll
                      for (int e = 0; e < 8; ++e) ss += v[e] * v[e];
                      const float rr = rsqrtf(wave_sum(ss) * (1.f / GW) + RMS_EPS);
#pragma unroll
                      for (int e = 0; e < 8; ++e) y[e] = v[e] * rr * P.gain[0 * GW + c8 + e] * (gt[e] * sigmoidf_(gt[e]));
                      *(GAS u32x4*)(prow + C_Q + c8) = pack8(y); }
                    { const LAS f32x4* hp = (const LAS f32x4*)(HL + tt * GW + c8); const f32x4 h0 = hp[0], h1 = hp[1];
                      v[0] = h0.x; v[1] = h0.y; v[2] = h0.z; v[3] = h0.w; v[4] = h1.x; v[5] = h1.y; v[6] = h1.z; v[7] = h1.w;
                      unpack8(*(const GAS u32x4*)(prow + C_GLRU + c8), gt);
                      float ss = 0.f;
#pragma unroll
                      for (int e = 0; e < 8; ++e) ss += v[e] * v[e];
                      const float rr = rsqrtf(wave_sum(ss) * (1.f / GW) + RMS_EPS);
#pragma unroll
                      for (int e = 0; e < 8; ++e) y[e] = v[e] * rr * P.gain[1 * GW + c8 + e] * (gt[e] * sigmoidf_(gt[e]));
                      *(GAS u32x4*)(prow + C_K + c8) = pack8(y); }
                    { float bb[8], cc[8], xx[8], cv[8];
#pragma unroll
                      for (int e = 0; e < 8; ++e) cv[e] = 0.f;
#pragma unroll
                      for (int kk = 0; kk < 3; ++kk) { const int tk = t + kk - 2;
                          if (tk >= 0) { const bf16* pr = PROJ + (rowb + tk) * INC; unpack8(*(const GAS u32x4*)(pr + C_SCC + c8), cc); unpack8(*(const GAS u32x4*)(pr + C_SCX + c8), xx);
#pragma unroll
                              for (int e = 0; e < 8; ++e) cv[e] += P.sc_w[kk * GW + c8 + e] * (cc[e] * xx[e]); } }
                      unpack8(*(const GAS u32x4*)(prow + C_SCB + c8), bb); unpack8(*(const GAS u32x4*)(prow + C_GSC + c8), gt);
                      float ss = 0.f;
#pragma unroll
                      for (int e = 0; e < 8; ++e) { v[e] = bb[e] * cv[e]; ss += v[e] * v[e]; }
                      const float rr = rsqrtf(wave_sum(ss) * (1.f / GW) + RMS_EPS);
#pragma unroll
                      for (int e = 0; e < 8; ++e) y[e] = v[e] * rr * P.gain[2 * GW + c8 + e] * (gt[e] * sigmoidf_(gt[e]));
                      *(GAS u32x4*)(prow + C_V + c8) = pack8(y); }
                }
                __syncthreads();
            }
        }
        if (PASS == 1) { f32x2* sp = (f32x2*)lrus + (size_t)(b * LRU_NT + tile) * GW + c; *sp = (f32x2){aprod, hst}; }
    }
}

__device__ __forceinline__ void ln_phase(Frame& F, float* X, bf16* XB, const float* g, const float* bta) {
    PHASE_IDS();
    const int gw = vcu * NWAVES + wave, NGW = F.G * NWAVES;
    f32x4 gv[4], bv[4];
#pragma unroll
    for (int jj = 0; jj < 4; ++jj) { gv[jj] = ((const GAS f32x4*)g)[lane + 64 * jj]; bv[jj] = ((const GAS f32x4*)bta)[lane + 64 * jj]; }
    for (int m = gw; m < T; m += NGW) {
        GAS f32x4* xr = (GAS f32x4*)(X + (size_t)m * DM) + lane;
        f32x4 v[4]; float s = 0.f;
#pragma unroll
        for (int jj = 0; jj < 4; ++jj) { v[jj] = xr[64 * jj]; s += (v[jj].x + v[jj].y) + (v[jj].z + v[jj].w); }
        const float mean = wave_sum(s) * (1.f / DM); float s2 = 0.f;
#pragma unroll
        for (int jj = 0; jj < 4; ++jj) { v[jj] = v[jj] - mean; s2 += (v[jj].x * v[jj].x + v[jj].y * v[jj].y) + (v[jj].z * v[jj].z + v[jj].w * v[jj].w); }
        const float rstd = rsqrtf(wave_sum(s2) * (1.f / DM) + LN_EPS);
        GAS u32x2* o8 = (GAS u32x2*)(XB + (size_t)m * DM) + lane;
#pragma unroll
        for (int jj = 0; jj < 4; ++jj) { const f32x4 y = v[jj] * rstd * gv[jj] + bv[jj]; xr[64 * jj] = y; u32x2 w; w.x = pk2(y.x, y.y); w.y = pk2(y.z, y.w); o8[64 * jj] = w; }
    }
}

__device__ __forceinline__ void xsoftmax_phase(Frame& F, const float* S, bf16* Pm) {
    PHASE_IDS();
    const int gw = vcu * NWAVES + wave, NGW = F.G * NWAVES;
    for (int it = gw; it < T * 4; it += NGW) {
        const f32x4 v = ((const GAS f32x4*)(S + (size_t)it * 256))[lane];
        const float mx = wave_max(fmaxf(fmaxf(v.x, v.y), fmaxf(v.z, v.w)));
        const float e0 = __builtin_amdgcn_exp2f(v.x - mx), e1 = __builtin_amdgcn_exp2f(v.y - mx), e2 = __builtin_amdgcn_exp2f(v.z - mx), e3 = __builtin_amdgcn_exp2f(v.w - mx);
        const float inv = 1.f / wave_sum((e0 + e1) + (e2 + e3));
        u32x2 w; w.x = pk2(e0 * inv, e1 * inv); w.y = pk2(e2 * inv, e3 * inv);
        ((GAS u32x2*)(Pm + (size_t)it * 256))[lane] = w;
    }
}

#ifndef MK_N_LAUNCHES
#define MK_N_LAUNCHES 1
#endif
constexpr int PH_PER_LAYER = 12, NPHASE = 1 + DEPTH * PH_PER_LAYER;

__global__ void __launch_bounds__(NWAVES * 64, 2) hymba_fwd(Args args) {
    extern __shared__ __attribute__((aligned(16))) unsigned char lds[];
    Frame F;
    F.lds = (LAS unsigned char*)lds;
    volatile LAS unsigned* MISC = (volatile LAS unsigned*)(F.lds + MISC_OFF);
    F.tid = threadIdx.x; F.lane = F.tid & 63; F.wave = __builtin_amdgcn_readfirstlane(F.tid >> 6);
    F.G = gridDim.x; { const int bx = blockIdx.x; F.vcu = (F.G % 8 == 0) ? (bx % 8) * (F.G / 8) + bx / 8 : bx; }
    unsigned char* ws = args.ws;
    for (int u = F.tid; u < (LDS_BYTES - LDSCTL_OFF) / 4; u += NWAVES * 64) ((LAS unsigned*)(F.lds + LDSCTL_OFF))[u] = 0u;
    __syncthreads();
    XcdBarrier bar; bar.bar = (unsigned*)(ws + WS_CTL) + CW_BAR; bar.x = 0; bar.st = nullptr;
    if (MK_N_LAUNCHES == 1) bar = xcd_barrier_post((unsigned*)(ws + WS_CTL) + CW_BAR, MISC + 8);
    const int lo = args.ph_lo, hi = args.ph_hi;
#define IN(k) (lo <= (k) && (k) < hi)
#define SEAM(k) do { if (IN(k) && IN((k) + 1)) xcd_barrier(bar); } while (0)

    bf16* XB = (bf16*)(ws + WS_XB); bf16* PROJ = (bf16*)(ws + WS_PROJ); bf16* MEMB = (bf16*)(ws + WS_MEMB);
    bf16* Q2 = (bf16*)(ws + WS_Q2); float* SS = (float*)(ws + WS_S); bf16* PP = (bf16*)(ws + WS_P); bf16* O2 = (bf16*)(ws + WS_O2);
    float* KMEAN = (float*)(ws + WS_KMEAN); float* LRUS = (float*)(ws + WS_LRUS);
    float* XR = args.out;

    if (IN(0)) { p0_prologue(F, args); }
    if (MK_N_LAUNCHES == 1) xcd_barrier_census(bar);
    SEAM(0);

    for (int l = 0; l < DEPTH; ++l) {
        const int pb = 1 + l * PH_PER_LAYER;
        unsigned char* wl = ws + WS_W + (size_t)l * W_LAYER;
        bf16* KMEM = (bf16*)(ws + WS_KMEM + (size_t)l * 2 * MiB); bf16* VMT = (bf16*)(ws + WS_VMT + (size_t)l * 2 * MiB);
        if (IN(pb + 0)) {
            { pg8::Gemm g = pg8::gemm_plain(MEMB, DM, (const bf16*)(wl + WO_K), DM, DM); pg8::StaticOrder S; S.init(BATCH * NMEM, DM, F.G, (int)blockIdx.x);
              pg8::EpiBf16 E{KMEM, DM, 1.f, 0}; pg8::gemm_phase<pg8::EpiBf16, pg8::StaticOrder, true>(F.lds + RING_OFF, g, S, E); }
            { pg8::Gemm g = pg8::gemm_plain((const bf16*)(wl + WO_V), DM, MEMB, DM, DM); pg8::StaticOrder S; S.init(DM, BATCH * NMEM, F.G, (int)blockIdx.x);
              pg8::EpiBf16 E{VMT, BATCH * NMEM, 1.f, 0}; pg8::gemm_phase<pg8::EpiBf16, pg8::StaticOrder, true>(F.lds + RING_OFF, g, S, E); }
            { pg8::Gemm g = pg8::gemm_plain(XB, DM, (const bf16*)(wl + WO_IN), DM, DM); pg8::StaticOrder S; S.init(T, INC, F.G, (int)blockIdx.x);
              pg8::EpiBf16 E{PROJ, INC, C2_ATT, GW}; pg8::gemm_phase<pg8::EpiBf16, pg8::StaticOrder, true>(F.lds + RING_OFF, g, S, E); }
        }
        SEAM(pb + 0);
        LruParams LP{args.in[3] + (size_t)l * 4 * GW, args.in[4] + (size_t)l * GW, args.in[5] + (size_t)l * NH * 64 * 64, args.in[6] + (size_t)l * GW,
                     args.in[7] + (size_t)l * NH * 64 * 64, args.in[8] + (size_t)l * GW, args.in[9] + (size_t)l * GW, args.in[10] + (size_t)l * 3 * GW, args.in[11] + (size_t)l * 3 * GW};
        if (IN(pb + 1)) { kmean_phase(F, PROJ, KMEAN); lru_phase<1>(F, PROJ, LRUS, LP); }
        SEAM(pb + 1);
        if (IN(pb + 2)) { moba_naive_phase(F, PROJ, KMEAN); }
        SEAM(pb + 2);
        if (IN(pb + 3)) { lru_phase<2>(F, PROJ, LRUS, LP); }
        SEAM(pb + 3);
        if (IN(pb + 4)) {
            pg8::Gemm g = pg8::gemm_plain(PROJ, INC, (const bf16*)(wl + WO_OUT), MIXW, MIXW); pg8::StaticOrder S; S.init(T, DM, F.G, (int)blockIdx.x);
            pg8::EpiF32Res E{l == 0 ? args.in[0] : XR, XR, DM, DN_ALPHA}; pg8::gemm_phase<pg8::EpiF32Res, pg8::StaticOrder, true>(F.lds + RING_OFF, g, S, E);
        }
        SEAM(pb + 4);
        if (IN(pb + 5)) { ln_phase(F, XR, XB, args.in[13] + (size_t)l * DM, args.in[14] + (size_t)l * DM); }
        SEAM(pb + 5);
        if (IN(pb + 6)) {
            pg8::Gemm g = pg8::gemm_plain(XB, DM, (const bf16*)(wl + WO_Q), DM, DM); pg8::StaticOrder S; S.init(T, DM, F.G, (int)blockIdx.x);
            pg8::EpiBf16 E{Q2, DM, C2_X, DM}; pg8::gemm_phase<pg8::EpiBf16, pg8::StaticOrder, true>(F.lds + RING_OFF, g, S, E);
        }
        SEAM(pb + 6);
        if (IN(pb + 7)) {
            pg8::Gemm g; g.A = opq((const bf16*)Q2); g.Bt = opq((const bf16*)KMEM); g.lda = DM; g.ldb = DM; g.K = 256; g.a_pm = (size_t)256 * DM; g.a_pn = 256; g.b_pn = 256; g.b_pb = (size_t)256 * DM;
            pg8::StaticOrder S; S.init(T, DM, F.G, (int)blockIdx.x);
            pg8::EpiF32Res E{nullptr, SS, DM, 0.f}; pg8::gemm_phase<pg8::EpiF32Res, pg8::StaticOrder, true>(F.lds + RING_OFF, g, S, E);
        }
        SEAM(pb + 7);
        if (IN(pb + 8)) { xsoftmax_phase(F, SS, PP); }
        SEAM(pb + 8);
        if (IN(pb + 9)) {
            pg8::Gemm g; g.A = opq((const bf16*)PP); g.Bt = opq((const bf16*)VMT); g.lda = DM; g.ldb = BATCH * NMEM; g.K = 256; g.a_pm = (size_t)256 * DM; g.a_pn = 256; g.b_pn = (size_t)256 * (BATCH * NMEM); g.b_pb = 256;
            pg8::StaticOrder S; S.init(T, DM, F.G, (int)blockIdx.x);
            pg8::EpiBf16 E{O2, DM, 1.f, 0}; pg8::gemm_phase<pg8::EpiBf16, pg8::StaticOrder, true>(F.lds + RING_OFF, g, S, E);
        }
        SEAM(pb + 9);
        if (IN(pb + 10)) {
            pg8::Gemm g = pg8::gemm_plain(O2, DM, (const bf16*)(wl + WO_O), DM, DM); pg8::StaticOrder S; S.init(T, DM, F.G, (int)blockIdx.x);
            pg8::EpiF32Res E{XR, XR, DM, DN_ALPHA}; pg8::gemm_phase<pg8::EpiF32Res, pg8::StaticOrder, true>(F.lds + RING_OFF, g, S, E);
        }
        SEAM(pb + 10);
        if (IN(pb + 11)) { ln_phase(F, XR, XB, args.in[19] + (size_t)l * DM, args.in[20] + (size_t)l * DM); }
        SEAM(pb + 11);
    }
#undef IN
#undef SEAM
}

extern "C" void kernel_launch(void* const* d_in, const int* in_sizes, int n_in, void* d_out, int out_size, void* d_ws, size_t ws_size, hipStream_t stream) {
    static int grid = 0;
    if (grid == 0) {
        if (n_in != 21 || in_sizes[0] != T * DM || out_size != T * DM || ws_size < WS_END) { fprintf(stderr, "kernel_launch: unexpected shapes (n_in %d, in0 %d, out %d, ws %zu); nothing launched\n", n_in, n_in > 0 ? in_sizes[0] : -1, out_size, ws_size); grid = -1; return; }
        int dev = 0, cus = 0;
        if (hipGetDevice(&dev) != hipSuccess || hipDeviceGetAttribute(&cus, hipDeviceAttributeMultiprocessorCount, dev) != hipSuccess) { grid = -1; return; }
        if (hipFuncSetAttribute((const void*)hymba_fwd, hipFuncAttributeMaxDynamicSharedMemorySize, LDS_BYTES) != hipSuccess) { fprintf(stderr, "kernel_launch: hipFuncSetAttribute failed\n"); grid = -1; return; }
        int per_cu = 0;
        if (hipOccupancyMaxActiveBlocksPerMultiprocessor(&per_cu, (const void*)hymba_fwd, NWAVES * 64, LDS_BYTES) != hipSuccess || per_cu < 1) fprintf(stderr, "kernel_launch: note: occupancy query reports %d\n", per_cu);
        (void)hipGetLastError();
        grid = cus;
    }
    if (grid < 0) return;
    if (hipMemsetAsync((char*)d_ws + WS_CTL, 0, CTL_ZERO_BYTES, stream) != hipSuccess) { fprintf(stderr, "kernel_launch: memset failed\n"); return; }
    Args a{};
    for (int i = 0; i < 21; ++i) a.in[i] = (const float*)d_in[i];
    a.out = (float*)d_out; a.ws = (unsigned char*)d_ws;
#if MK_N_LAUNCHES == 1
    a.ph_lo = 0; a.ph_hi = NPHASE;
    hipLaunchKernelGGL(hymba_fwd, dim3(grid), dim3(NWAVES * 64), LDS_BYTES, stream, a);
#else
    for (int p = 0; p < NPHASE; ++p) { a.ph_lo = p; a.ph_hi = p + 1; hipLaunchKernelGGL(hymba_fwd, dim3(grid), dim3(NWAVES * 64), LDS_BYTES, stream, a); }
#endif
}
```

```cpp
#include <hip/hip_runtime.h>
#include <hip/hip_bf16.h>
#include <cstdio>
#include <cstdint>
#include <cmath>

#define LAS __attribute__((address_space(3)))
#define GAS __attribute__((address_space(1)))
typedef unsigned short bf16;
typedef short bf16x8 __attribute__((ext_vector_type(8)));
typedef float f32x4 __attribute__((ext_vector_type(4)));
typedef float f32x2 __attribute__((ext_vector_type(2)));
typedef unsigned u32x4 __attribute__((ext_vector_type(4)));
typedef unsigned u32x2 __attribute__((ext_vector_type(2)));

constexpr int BATCH = 4, SEQ = 8192, DM = 1024, T = BATCH * SEQ, DEPTH = 2, NMEM = 256;
constexpr int GW = 512, MIXW = 1536, INC = 5120, NH = 8, HD = 64, MBLK = 256, NBLK = SEQ / MBLK;
constexpr int C_Q = 0, C_K = 512, C_V = 1024, C_GATT = 1536, C_XLRU = 2048, C_GLRU = 2560, C_SCB = 3072, C_SCC = 3584, C_SCX = 4096, C_GSC = 4608;
constexpr float DN_ALPHA = 1.41421356237309515f;
constexpr float LN_EPS = 1e-5f, RMS_EPS = 1e-6f;
constexpr float LOG2E = 1.4426950408889634f;
constexpr float C2_ATT = 0.125f * LOG2E;
constexpr float C2_X = 0.0625f * LOG2E;
constexpr int LRU_TILE = 128, LRU_NT = SEQ / LRU_TILE;

constexpr size_t MiB = 1u << 20;
constexpr size_t WS_CTL = 0, CTL_ZERO_BYTES = 1 * MiB;
constexpr size_t WS_W = 2 * MiB, W_LAYER = 21 * MiB;
constexpr size_t WO_IN = 0, WO_OUT = 10 * MiB, WO_Q = 13 * MiB, WO_K = 15 * MiB, WO_V = 17 * MiB, WO_O = 19 * MiB;
constexpr size_t WS_MEMB = 44 * MiB, WS_KMEM = 46 * MiB, WS_VMT = 50 * MiB, WS_KMEAN = 54 * MiB, WS_LRUS = 55 * MiB;
constexpr size_t WS_XB = 64 * MiB, WS_PROJ = 128 * MiB;
constexpr size_t WS_Q2 = 128 * MiB, WS_S = 192 * MiB, WS_P = 320 * MiB, WS_O2 = 384 * MiB, WS_END = 448 * MiB;
constexpr int CW_BAR = 4096;

__device__ __forceinline__ float bf2f(unsigned h) { return __uint_as_float(h << 16); }
__device__ __forceinline__ unsigned f2bf(float f) { unsigned u = __float_as_uint(f); return (u + 0x7fffu + ((u >> 16) & 1u)) >> 16; }
__device__ __forceinline__ unsigned pk2(float lo, float hi) { return f2bf(lo) | (f2bf(hi) << 16); }
__device__ __forceinline__ void unpack8(const u32x4 w, float* f) {
    f[0] = __uint_as_float(w.x << 16); f[1] = __uint_as_float(w.x & 0xffff0000u); f[2] = __uint_as_float(w.y << 16); f[3] = __uint_as_float(w.y & 0xffff0000u);
    f[4] = __uint_as_float(w.z << 16); f[5] = __uint_as_float(w.z & 0xffff0000u); f[6] = __uint_as_float(w.w << 16); f[7] = __uint_as_float(w.w & 0xffff0000u);
}
__device__ __forceinline__ u32x4 pack8(const float* f) { u32x4 w; w.x = pk2(f[0], f[1]); w.y = pk2(f[2], f[3]); w.z = pk2(f[4], f[5]); w.w = pk2(f[6], f[7]); return w; }
__device__ __forceinline__ float wave_sum(float v) {
#pragma unroll
    for (int o = 1; o < 64; o <<= 1) v += __shfl_xor(v, o);
    return v;
}
__device__ __forceinline__ float wave_max(float v) {
#pragma unroll
    for (int o = 1; o < 64; o <<= 1) v = fmaxf(v, __shfl_xor(v, o));
    return v;
}
__device__ __forceinline__ float sigmoidf_(float x) { return 1.f / (1.f + __expf(-x)); }
template <class Tp> __device__ __forceinline__ Tp* opq(Tp* p) { asm volatile("" : "+s"(p)); return (Tp*)(GAS Tp*)p; }
__device__ __forceinline__ int opq_v(int v) { asm volatile("" : "+v"(v)); return v; }
__device__ __forceinline__ int opq_s(int v) { asm volatile("" : "+s"(v)); return v; }
#define PHASE_IDS() const int tid = opq_v(F.tid); const int lane = tid & 63; const int wave = opq_s(F.wave); const int vcu = opq_s(F.vcu); (void)tid; (void)lane; (void)wave; (void)vcu
#define LDS_WAIT() asm volatile("s_waitcnt lgkmcnt(0)" ::: "memory")
#define VM_WAIT() asm volatile("s_waitcnt vmcnt(0)" ::: "memory")

namespace pg8 {
constexpr int BM = 256, BK = 64, HALF = 128, HTB = HALF * BK * 2, STAGE_BYTES = 8 * HTB, NXCD = 8, WGM = 8;
__host__ __device__ __forceinline__ int lds_byte(int r, int c) { const int st = (r >> 4) * 2 + (c >> 5), rr = r & 15, cc = c & 31, ob = rr * 64 + cc * 2; return st * 1024 + (ob ^ (((ob >> 9) & 1) << 5)); }
__host__ __device__ __forceinline__ void stage_rc(int b, int& R, int& C) { const int st = b / 1024, sb = b % 1024, swz = sb ^ (((sb >> 9) & 1) << 5); R = (st >> 1) * 16 + swz / 64; C = (st & 1) * 32 + (swz % 64) / 2; }
__host__ __device__ __forceinline__ int perm32(int rho) { const int n = rho >> 4, i = rho & 15; return 8 * (i >> 2) + 4 * n + (i & 3); }

struct Unit { int pm, pn; };
struct Gemm {
    const bf16* A; const bf16* Bt; int lda, ldb, K; size_t a_pm, a_pn, b_pn, b_pb;
    __device__ __forceinline__ const char* aptr(const Unit& u) const { return (const char*)(A + (size_t)u.pm * a_pm + (size_t)u.pn * a_pn); }
    __device__ __forceinline__ const char* bptr(const Unit& u) const { return (const char*)(Bt + (size_t)u.pn * b_pn + (size_t)(u.pm >> 5) * b_pb); }
};
__device__ __forceinline__ Gemm gemm_plain(const bf16* A, int lda, const bf16* Bt, int ldb, int K) { Gemm g; g.A = opq(A); g.Bt = opq(Bt); g.lda = lda; g.ldb = ldb; g.K = K; g.a_pm = (size_t)256 * lda; g.a_pn = 0; g.b_pn = (size_t)256 * ldb; g.b_pb = 0; return g; }

struct StaticOrder {
    int nM, nN, nwg, G, c;
    __host__ __device__ void init(int M, int N, int G_, int c_) { nM = M / BM; nN = N / BM; nwg = nM * nN; G = G_; c = c_; }
    __host__ __device__ bool next(int i, Unit& u) const {
        const long L = (long)i * G + c; if (L >= nwg) return false;
        int wgid = (int)L; { const int q = nwg / NXCD, r = nwg % NXCD, xcd = wgid % NXCD, off = wgid / NXCD; wgid = (xcd < r ? xcd * (q + 1) : r * (q + 1) + (xcd - r) * q) + off; }
        const int nig = WGM * nN, gid = wgid / nig, fm = gid * WGM, gsz = (nM - fm) < WGM ? (nM - fm) : WGM;
        u.pm = fm + ((wgid % nig) % gsz); u.pn = (wgid % nig) / gsz; return true;
    }
};

__device__ __forceinline__ unsigned cvt_pk_bf16(float lo, float hi) { unsigned r; asm volatile("v_cvt_pk_bf16_f32 %0, %1, %2" : "=v"(r) : "v"(lo), "v"(hi)); return r; }

struct EpiBf16 {
    static constexpr bool PERM = true;
    bf16* O; int ldc; float scale_lo; int ncols_lo;
    __device__ __forceinline__ void operator()(const f32x4 (&acc)[2][2][4][2], const Unit& u, int wr, int wc, int fr, int fq) const {
        const int row0 = u.pm * BM + wr * 64 + fr, col0 = u.pn * BM + wc * 32 + 8 * fq;
        const float sc = (u.pn * BM < ncols_lo) ? scale_lo : 1.f;
#pragma unroll
        for (int ai = 0; ai < 2; ++ai)
#pragma unroll
            for (int m = 0; m < 4; ++m) { bf16* rowp = O + (size_t)(row0 + ai * HALF + m * 16) * ldc + col0;
#pragma unroll
                for (int bj = 0; bj < 2; ++bj) { const f32x4 v0 = acc[ai][bj][m][0] * sc, v1 = acc[ai][bj][m][1] * sc;
                    u32x4 w; w.x = cvt_pk_bf16(v0[0], v0[1]); w.y = cvt_pk_bf16(v0[2], v0[3]); w.z = cvt_pk_bf16(v1[0], v1[1]); w.w = cvt_pk_bf16(v1[2], v1[3]);
                    *(u32x4*)(rowp + bj * HALF) = w; } }
    }
};
struct EpiF32Res {
    static constexpr bool PERM = false;
    const float* base; float* out; int ldc; float alpha;
    __device__ __forceinline__ void operator()(const f32x4 (&acc)[2][2][4][2], const Unit& u, int wr, int wc, int fr, int fq) const {
        const int row0 = u.pm * BM + wr * 64 + fr, col0 = u.pn * BM + wc * 32 + 4 * fq;
#pragma unroll
        for (int ai = 0; ai < 2; ++ai)
#pragma unroll
            for (int m = 0; m < 4; ++m) { const size_t off = (size_t)(row0 + ai * HALF + m * 16) * ldc + col0;
#pragma unroll
                for (int bj = 0; bj < 2; ++bj)
#pragma unroll
                    for (int n = 0; n < 2; ++n) { f32x4 v = acc[ai][bj][m][n];
                        if (base) { const f32x4 bs = *(const f32x4*)(base + off + bj * HALF + n * 16); v = v + bs * alpha; }
                        *(f32x4*)(out + off + bj * HALF + n * 16) = v; } }
    }
};

template <class Epi, class Sched, bool ALIGN_EPI>
__device__ __forceinline__ void gemm_phase(LAS unsigned char* lds, const Gemm g, const Sched& S, const Epi& E) {
    const int tid = opq_v((int)threadIdx.x), wid = __builtin_amdgcn_readfirstlane(tid >> 6), lane = tid & 63, wr = wid >> 2, wc = wid & 3, fr = lane & 15, fq = lane >> 4;
    const int K = g.K, nt = K / BK;
    unsigned voffA[2], voffB[2];
#pragma unroll
    for (int i = 0; i < 2; ++i) { int R, C; stage_rc(tid * 16 + i * 8192, R, C); const int Rb = Epi::PERM ? ((R & ~31) + perm32(R & 31)) : R;
        voffA[i] = (unsigned)(R * g.lda + C) * 2u; voffB[i] = (unsigned)(Rb * g.ldb + C) * 2u; }
    const size_t kstep = (size_t)(BK * 2);
    const size_t hstepA = (size_t)HALF * g.lda * 2, hstepB = (size_t)HALF * g.ldb * 2;
    const unsigned ldsw = (unsigned)wid * 1024u;
    const int aoff = lds_byte(wr * 64 + fr, fq * 8), boff = lds_byte(wc * 32 + fr, fq * 8);
#define PG8_SA(b, h) (((b) * 2 + (h)) * HTB)
#define PG8_SB(b, h) ((4 + (b) * 2 + (h)) * HTB)
#define PG8_STAGE(bufoff, gbase, voff) do { _Pragma("unroll") for (int _i = 0; _i < 2; ++_i) \
        __builtin_amdgcn_global_load_lds((const unsigned*)((const char*)(gbase) + (voff)[_i]), (LAS unsigned*)(lds + (bufoff) + ldsw + _i * 8192), 16, 0, 0); } while (0)
#define PG8_LDA(dst, b, h) do { _Pragma("unroll") for (int m = 0; m < 4; ++m) _Pragma("unroll") for (int k = 0; k < 2; ++k) dst[m][k] = *(const LAS bf16x8*)(lds + PG8_SA(b, h) + aoff + m * 2048 + k * 1024); } while (0)
#define PG8_LDB(dst, b, h) do { _Pragma("unroll") for (int n = 0; n < 2; ++n) _Pragma("unroll") for (int k = 0; k < 2; ++k) dst[n][k] = *(const LAS bf16x8*)(lds + PG8_SB(b, h) + boff + n * 2048 + k * 1024); } while (0)
#define PG8_MMA(ai, bj, At, Bt) do { __builtin_amdgcn_s_setprio(1); _Pragma("unroll") for (int m = 0; m < 4; ++m) _Pragma("unroll") for (int n = 0; n < 2; ++n) _Pragma("unroll") for (int k = 0; k < 2; ++k) \
        acc[ai][bj][m][n] = __builtin_amdgcn_mfma_f32_16x16x32_bf16(Bt[n][k], At[m][k], acc[ai][bj][m][n], 0, 0, 0); __builtin_amdgcn_s_setprio(0); } while (0)
#define PG8_WAIT_V(n) asm volatile("s_waitcnt vmcnt(" #n ")" ::: "memory")
#define PG8_WAIT_L(n) asm volatile("s_waitcnt lgkmcnt(" #n ")" ::: "memory")
#define PG8_BAR __builtin_amdgcn_s_barrier()
#define PG8_SCHED __builtin_amdgcn_sched_barrier(0)
    Unit cur, nxt; int ui = 0;
    if (!S.next(0, cur)) return;
    f32x4 acc[2][2][4][2];
#pragma unroll
    for (int a = 0; a < 2; ++a)
#pragma unroll
        for (int b = 0; b < 2; ++b)
#pragma unroll
            for (int m = 0; m < 4; ++m)
#pragma unroll
                for (int n = 0; n < 2; ++n) acc[a][b][m][n] = (f32x4){0.f, 0.f, 0.f, 0.f};
    bf16x8 At[4][2], B0[2][2], B1[2][2];
    const char* cA = g.aptr(cur); const char* cB = g.bptr(cur);
    PG8_STAGE(PG8_SB(0, 0), cB, voffB); PG8_STAGE(PG8_SB(0, 1), cB + hstepB, voffB); PG8_STAGE(PG8_SA(0, 0), cA, voffA); PG8_STAGE(PG8_SA(0, 1), cA + hstepA, voffA);
    if (wr == 1) PG8_BAR;
    PG8_WAIT_V(2); PG8_BAR;
    PG8_STAGE(PG8_SB(1, 0), cB + kstep, voffB); PG8_STAGE(PG8_SA(1, 0), cA + kstep, voffA); PG8_STAGE(PG8_SB(1, 1), cB + hstepB + kstep, voffB);
    PG8_WAIT_V(6); PG8_BAR;
    for (;;) {
        const bool has_next = S.next(ui + 1, nxt);
        const char* nA = has_next ? g.aptr(nxt) : cA; const char* nB = has_next ? g.bptr(nxt) : cB;
        for (int t = 0; t < nt; t += 2) {
            const bool last = (t == nt - 2);
            const char* a1 = cA + (size_t)(t + 1) * kstep;
            const char* a2 = last ? nA : cA + (size_t)(t + 2) * kstep; const char* b2 = last ? nB : cB + (size_t)(t + 2) * kstep;
            const char* a3 = a2 + kstep; const char* b3 = b2 + kstep;
            PG8_LDB(B0, 0, 0); PG8_LDB(B1, 0, 1); PG8_SCHED; PG8_LDA(At, 0, 0); PG8_STAGE(PG8_SA(1, 1), a1 + hstepA, voffA);
            PG8_WAIT_V(8); PG8_WAIT_L(0); PG8_BAR; PG8_MMA(0, 0, At, B0); PG8_MMA(0, 1, At, B1); PG8_BAR; PG8_SCHED;
            PG8_LDA(At, 0, 1); PG8_STAGE(PG8_SB(0, 0), b2, voffB); PG8_STAGE(PG8_SB(0, 1), b2 + hstepB, voffB); PG8_STAGE(PG8_SA(0, 0), a2, voffA);
            PG8_WAIT_V(8); PG8_WAIT_L(0); PG8_BAR; PG8_MMA(1, 0, At, B0); PG8_MMA(1, 1, At, B1); PG8_BAR; PG8_SCHED;
            PG8_LDB(B0, 1, 0); PG8_LDB(B1, 1, 1); PG8_SCHED; PG8_LDA(At, 1, 0); PG8_STAGE(PG8_SA(0, 1), a2 + hstepA, voffA);
            PG8_WAIT_V(8); PG8_WAIT_L(0); PG8_BAR; PG8_MMA(0, 0, At, B0); PG8_MMA(0, 1, At, B1); PG8_BAR; PG8_SCHED;
            PG8_LDA(At, 1, 1); PG8_STAGE(PG8_SB(1, 0), b3, voffB); PG8_STAGE(PG8_SB(1, 1), b3 + hstepB, voffB); PG8_STAGE(PG8_SA(1, 0), a3, voffA);
            PG8_WAIT_V(8); PG8_WAIT_L(0); PG8_BAR; PG8_MMA(1, 0, At, B0); PG8_MMA(1, 1, At, B1); PG8_BAR; PG8_SCHED;
        }
        if constexpr (ALIGN_EPI) { if (wr == 0) PG8_BAR; }
        E(acc, cur, wr, wc, fr, fq);
        if (!has_next) break;
#pragma unroll
        for (int a = 0; a < 2; ++a)
#pragma unroll
            for (int b = 0; b < 2; ++b)
#pragma unroll
                for (int m = 0; m < 4; ++m)
#pragma unroll
                    for (int n = 0; n < 2; ++n) acc[a][b][m][n] = (f32x4){0.f, 0.f, 0.f, 0.f};
        cur = nxt; cA = nA; cB = nB; ++ui;
        if constexpr (ALIGN_EPI) { if (wr == 1) PG8_BAR; }
    }
    PG8_WAIT_V(0);
    if constexpr (!ALIGN_EPI) { if (wr == 0) PG8_BAR; }
    PG8_BAR;
#undef PG8_SA
#undef PG8_SB
#undef PG8_STAGE
#undef PG8_LDA
#undef PG8_LDB
#undef PG8_MMA
#undef PG8_WAIT_V
#undef PG8_WAIT_L
#undef PG8_BAR
#undef PG8_SCHED
}
}

namespace moba_body {
using bf16=__hip_bfloat16;
using bf16x8=__attribute__((ext_vector_type(8)))short;
using s16x4=__attribute__((ext_vector_type(4)))short;
using f32x16=__attribute__((ext_vector_type(16)))float;
using u32x4=__attribute__((ext_vector_type(4)))unsigned;
constexpr int BATCH=4,NHEAD=8,SEQ=8192,D=64,DM=5120;
constexpr int NW=8,QBLK=32,QB=QBLK*NW,KVBLK=64,NQB=SEQ/QB;
constexpr int ATTN_PITCH=DM, ATTN_UNIT_ROWS=QB;
__device__ __forceinline__ int crow(int r,int hi){return (r&3)+8*(r>>2)+4*hi;}
#define SBAR() __builtin_amdgcn_sched_barrier(0)
__device__ __forceinline__ void cmask(f32x16&p0,f32x16&p1,int jb,int qrel,int hi){
  const float NEG=-INFINITY; int kb=64*jb+4*hi;
  #pragma unroll
  for(int r=0;r<16;++r){int kv=kb+(r&3)+8*(r>>2); if(kv>qrel)p0[r]=NEG; if(kv+32>qrel)p1[r]=NEG;}
}

constexpr int NSLOT=3, SLOTB=8192;
constexpr int LDS_K=0, LDS_V=NSLOT*SLOTB, LDS_WS=2*NSLOT*SLOTB, LDS_OST=LDS_WS+NW*64*4, LDS_BYTES=LDS_OST+NW*4096;
constexpr float C2=0.125f*1.4426950408889634f;
__device__ __forceinline__ void glds16(const void*gsrc,unsigned lds_dst){unsigned keep;
  asm volatile("s_mov_b32 %0, m0\n\ts_mov_b32 m0, %2\n\ts_nop 0\n\tglobal_load_lds_dwordx4 %1, off\n\ts_mov_b32 m0, %0":"=&s"(keep):"v"(gsrc),"s"(lds_dst):"memory");}
__device__ __forceinline__ float max3f(float a,float b,float c){float r;asm("v_max3_f32 %0, %1, %2, %3":"=v"(r):"v"(a),"v"(b),"v"(c));return r;}
__device__ __forceinline__ float max2f(float a,float b){float r;asm("v_max_f32_e32 %0, %1, %2":"=v"(r):"v"(a),"v"(b));return r;}
__device__ __forceinline__ float fadd_s(float a,float b){float r;asm("v_add_f32_e32 %0, %1, %2":"=v"(r):"v"(a),"v"(b));return r;}
__device__ __forceinline__ float fsub_s(float a,float b){float r;asm("v_sub_f32_e32 %0, %1, %2":"=v"(r):"v"(a),"v"(b));return r;}
typedef float f32x2_t __attribute__((ext_vector_type(2))); typedef __bf16 bf16x2_t __attribute__((ext_vector_type(2)));
__device__ __forceinline__ unsigned cvtpk_s(float lo,float hi){f32x2_t v={lo,hi};bf16x2_t b=__builtin_convertvector(v,bf16x2_t);return __builtin_bit_cast(unsigned,b);}
#define WAIT_BAR(N) asm volatile("s_waitcnt vmcnt(" #N ") lgkmcnt(0)\n\ts_barrier":::"memory")

__device__ __forceinline__ void qkt(f32x16&p0,f32x16&p1,const char*Kslot,const bf16x8*qr,const f32x16&negm,int r32,int hi){
  const char*kb=Kslot+hi*1024+r32*16;
  #pragma unroll
  for(int d0=0;d0<4;++d0){
    const bf16x8 b0=*reinterpret_cast<const bf16x8*>(kb+d0*2048);
    const bf16x8 b1=*reinterpret_cast<const bf16x8*>(kb+d0*2048+512);
    if(d0==0){p0=__builtin_amdgcn_mfma_f32_32x32x16_bf16(b0,qr[0],negm,0,0,0);p1=__builtin_amdgcn_mfma_f32_32x32x16_bf16(b1,qr[0],negm,0,0,0);}
    else{p0=__builtin_amdgcn_mfma_f32_32x32x16_bf16(b0,qr[d0],p0,0,0,0);p1=__builtin_amdgcn_mfma_f32_32x32x16_bf16(b1,qr[d0],p1,0,0,0);}}
}
typedef __attribute__((address_space(3))) const char* lds_cptr;
typedef short v4i16_t __attribute__((ext_vector_type(4)));
__device__ __forceinline__ void kload8(bf16x8*kf,lds_cptr kp){
  kf[0]=*(const __attribute__((address_space(3))) bf16x8*)(kp);      kf[1]=*(const __attribute__((address_space(3))) bf16x8*)(kp+512);
  kf[2]=*(const __attribute__((address_space(3))) bf16x8*)(kp+2048); kf[3]=*(const __attribute__((address_space(3))) bf16x8*)(kp+2560);
  kf[4]=*(const __attribute__((address_space(3))) bf16x8*)(kp+4096); kf[5]=*(const __attribute__((address_space(3))) bf16x8*)(kp+4608);
  kf[6]=*(const __attribute__((address_space(3))) bf16x8*)(kp+6144); kf[7]=*(const __attribute__((address_space(3))) bf16x8*)(kp+6656);
}
__device__ __forceinline__ void kload2(bf16x8*kf,lds_cptr kp,int j){ kf[2*j]=*(const __attribute__((address_space(3))) bf16x8*)(kp+j*2048); kf[2*j+1]=*(const __attribute__((address_space(3))) bf16x8*)(kp+j*2048+512); }
__device__ __forceinline__ s16x4 vtr(lds_cptr p){ return __builtin_bit_cast(s16x4,__builtin_amdgcn_ds_read_tr16_b64_v4i16((__attribute__((address_space(3))) v4i16_t*)p)); }
__device__ __forceinline__ float rowmax(const f32x16&p0,const f32x16&p1){
  float a=max3f(p0[0],p0[1],p1[0]),b=max3f(p0[2],p0[3],p1[1]);a=max3f(a,p1[2],p1[3]);
  #pragma unroll
  for(int r=4;r<16;r+=4){a=max3f(a,p0[r],p0[r+1]);b=max3f(b,p0[r+2],p0[r+3]);a=max3f(a,p1[r],p1[r+1]);b=max3f(b,p1[r+2],p1[r+3]);}
  const float m=max2f(a,b);
  auto rr=__builtin_amdgcn_permlane32_swap(__float_as_uint(m),__float_as_uint(m),false,false);
  return max2f(__uint_as_float(rr[0]),__uint_as_float(rr[1]));
}
__device__ __forceinline__ void pv(f32x16*o,int vb,bf16x8 pa0,bf16x8 pa1,bf16x8 pa2,bf16x8 pa3){
  #pragma unroll
  for(int d0=0;d0<2;++d0){s16x4 lo[4],hi[4];
    #pragma unroll
    for(int ks=0;ks<4;++ks){
      asm volatile("ds_read_b64_tr_b16 %0,%1 offset:%c2":"=&v"(lo[ks]):"v"(vb),"i"(d0*4096+ks*1024):"memory");
      asm volatile("ds_read_b64_tr_b16 %0,%1 offset:%c2":"=&v"(hi[ks]):"v"(vb),"i"(d0*4096+ks*1024+512):"memory");}
    asm volatile("s_waitcnt lgkmcnt(0)":::"memory");SBAR();
    #define PK(k) (bf16x8){lo[k][0],lo[k][1],lo[k][2],lo[k][3],hi[k][0],hi[k][1],hi[k][2],hi[k][3]}
    o[d0]=__builtin_amdgcn_mfma_f32_32x32x16_bf16(pa0,PK(0),o[d0],0,0,0);
    o[d0]=__builtin_amdgcn_mfma_f32_32x32x16_bf16(pa1,PK(1),o[d0],0,0,0);
    o[d0]=__builtin_amdgcn_mfma_f32_32x32x16_bf16(pa2,PK(2),o[d0],0,0,0);
    o[d0]=__builtin_amdgcn_mfma_f32_32x32x16_bf16(pa3,PK(3),o[d0],0,0,0);
    #undef PK
  }
}

#ifndef ATTN_STORE16
#define ATTN_STORE16(p,v) (*(GAS u32x4*)(p)=(v))
#endif
template<int THRL> __device__ __forceinline__ void attn_unit(int b,int h,int qb,const bf16*Q,const bf16*__restrict__ K,const bf16*__restrict__ V,bf16*O,const unsigned short*__restrict__ KMB,char*shm){
  const int tid=opq_v((int)threadIdx.x),lane=tid&63,r32=lane&31,hi=lane>>5; const int wid=__builtin_amdgcn_readfirstlane(tid>>6);
  const long rowbase=(long)b*SEQ; const int q0=qb*QB;
  const bf16*Qw=Q+(rowbase+q0+wid*QBLK)*DM+h*D;
  const bf16*Kh=K+rowbase*DM+h*D,*Vh=V+rowbase*DM+h*D;
  const unsigned lds0=(unsigned)(uintptr_t)shm;
  float*wsf=(float*)(shm+LDS_WS)+wid*64;
  const bf16*ksrc=Kh+(long)lane*DM+wid*8;
  const bf16*vsrc=Vh+(long)(16*(wid&3)+(lane>>2))*DM+(wid>>2)*32+(lane&3)*8;
  const unsigned kdst=lds0+LDS_K+wid*1024, vdst=lds0+LDS_V+wid*1024;
  #define KT(t) (((t)<4)?((t)+NT-4):((t)-4))
  #define DMA_K(t,slot) glds16(ksrc+(long)KT(t)*KVBLK*DM,(unsigned)__builtin_amdgcn_readfirstlane(kdst+(slot)))
  #define DMA_V(t,slot) glds16(vsrc+(long)KT(t)*KVBLK*DM,(unsigned)__builtin_amdgcn_readfirstlane(vdst+(slot)))
  const int vb0=(int)(lds0+LDS_V)+((lane>>4)&1)*32+(lane&3)*8+(4*hi+((lane&15)>>2))*64;
  const char*Kbase=shm+LDS_K; bf16x8 kf[8];
  const lds_cptr shm3=(lds_cptr)shm; const lds_cptr kp0=shm3+LDS_K+hi*1024+r32*16; const lds_cptr vp0=shm3+LDS_V+((lane>>4)&1)*32+(lane&3)*8+(4*hi+((lane&15)>>2))*64;
  const int NT=(q0+QB)/KVBLK;
  DMA_K(0,0);DMA_V(0,0);DMA_K(1,SLOTB);
  bf16x8 qr[4];
  #pragma unroll
  for(int d0=0;d0<4;++d0)qr[d0]=*(const GAS bf16x8*)(&Qw[(long)r32*DM+d0*16+hi*8]);

  unsigned selmask=0u;
  { f32x16 G=f32x16{};
    const unsigned short*kmp=KMB+((size_t)(b*NHEAD+h)*32+r32)*64+hi*8;
    #pragma unroll
    for(int d0=0;d0<4;++d0){ const bf16x8 kmf=*(const GAS bf16x8*)(kmp+d0*16); G=__builtin_amdgcn_mfma_f32_32x32x16_bf16(kmf,qr[d0],G,0,0,0); }
    float v0=-INFINITY,v1=-INFINITY,v2=-INFINITY; int j0=64,j1=64,j2=64;
    #pragma unroll
    for(int r=0;r<16;++r){ const int j=crow(r,hi); const float g=(j<qb)?G[r]:-INFINITY;
      if(g>v0){v2=v1;j2=j1;v1=v0;j1=j0;v0=g;j0=j;} else if(g>v1){v2=v1;j2=j1;v1=g;j1=j;} else if(g>v2){v2=g;j2=j;} }
    const float w0=__shfl_xor(v0,32),w1=__shfl_xor(v1,32),w2=__shfl_xor(v2,32); const int k0=__shfl_xor(j0,32),k1=__shfl_xor(j1,32),k2=__shfl_xor(j2,32);
    #define BETTER(va,ja,vb,jb) ((va)>(vb)||((va)==(vb)&&(ja)<(jb)))
    #define INS(g,j) do{ if(BETTER(g,j,v0,j0)){v2=v1;j2=j1;v1=v0;j1=j0;v0=g;j0=j;} else if(BETTER(g,j,v1,j1)){v2=v1;j2=j1;v1=g;j1=j;} else if(BETTER(g,j,v2,j2)){v2=g;j2=j;} }while(0)
    INS(w0,k0);INS(w1,k1);INS(w2,k2);
    #undef INS
    #undef BETTER
    if(v0>-INFINITY)selmask|=1u<<j0; if(v1>-INFINITY)selmask|=1u<<j1; if(v2>-INFINITY)selmask|=1u<<j2;
  }
  float mhat=0.f,l_reg=0.f;f32x16 o[2];o[0]=f32x16{};o[1]=f32x16{};f32x16 negm=f32x16{};asm volatile("":"+v"(negm));
  const int qrel=wid*QBLK+r32;
  #define CMASK(P0,P1,t) do{int jb_=(t); if(jb_<4)cmask(P0,P1,jb_,qrel,hi);}while(0)
  bool resc=false;
  #define START(P0,P1) do{ const float rm=rowmax(P0,P1); resc=false; \
    { const float dl=rm; mhat=fadd_s(mhat,dl); \
      _Pragma("unroll") for(int r=0;r<16;++r){P0[r]=fsub_s(P0[r],dl);P1[r]=fsub_s(P1[r],dl);} \
      _Pragma("unroll") for(int r=0;r<16;++r)negm[r]=-mhat; asm volatile("":"+v"(negm)); } \
    _Pragma("unroll") for(int r=0;r<16;++r)P0[r]=__builtin_amdgcn_exp2f(P0[r]); }while(0)
  #define RESC() do{ if(resc){ asm volatile("s_waitcnt lgkmcnt(0)":::"memory"); \
      _Pragma("unroll") for(int d_=0;d_<2;++d_) _Pragma("unroll") for(int r=0;r<16;++r)o[d_][r]*=wsf[crow(r,hi)]; } }while(0)
  f32x16 pA0,pA1,pB0,pB1;
  int sl_prev=0,sl_cur=0,sl_next=SLOTB;
  #define ROT() do{sl_prev=sl_cur;sl_cur=sl_next;sl_next=(sl_next==(NSLOT-1)*SLOTB)?0:sl_next+SLOTB;}while(0)
  DMA_K(2,2*SLOTB);
  WAIT_BAR(3);
  qkt(pA0,pA1,Kbase,qr,negm,r32,hi);asm volatile("s_nop 15\n\ts_nop 7":"+v"(pA0),"+v"(pA1));CMASK(pA0,pA1,0);
  START(pA0,pA1);
  _Pragma("unroll") for(int r=0;r<16;++r)pA1[r]=__builtin_amdgcn_exp2f(pA1[r]);
  WAIT_BAR(0);
  DMA_K(3,0);DMA_V(1,SLOTB);
  ROT();
  kload8(kf,kp0+sl_cur);
  WAIT_BAR(2);
  s16x4 vlo[8],vhi[8]; u32x4 pw0,pw1,pw2,pw3;
  #define PKW(P,B) cvtpk_s(P[B],P[B+1])
  #define PAF(k) __builtin_bit_cast(bf16x8,pw##k)
  #define VFR(i) (bf16x8){vlo[i][0],vlo[i][1],vlo[i][2],vlo[i][3],vhi[i][0],vhi[i][1],vhi[i][2],vhi[i][3]}
  #define PIN(x) asm volatile("":"+v"(x))
  #define MX3(a,b,c) __builtin_fmaxf(__builtin_fmaxf((a),(b)),(c))
  #define GAPA(MF,A0,A1,A2,A3,W0,W1,PW) do{ MF; sacc+=A0; sacc+=A1; sacc+=A2; sacc+=A3; PIN(sacc); W0; W1; PIN(PW); SBAR(); }while(0)
  #define EX(v) __builtin_amdgcn_exp2f(v)
  #define GAPB(MF,X,B) do{ MF; X[B]=EX(X[B]); X[B+1]=EX(X[B+1]); X[B+2]=EX(X[B+2]); X[B+3]=EX(X[B+3]); PIN(X); SBAR(); }while(0)
  #define VRD(i) do{ vlo[i]=vtr(vp_+(((i)>>2)*4096+((i)&3)*1024)); vhi[i]=vtr(vp_+(((i)>>2)*4096+((i)&3)*1024+512)); }while(0)
  #define KRD(G,j) do{ if(G){ kload2(kf,kp0+sl_next,j); SBAR(); } }while(0)
  #define STEP(C0,C1,P0,P1,t,GK,GV,GL) do{ SBAR(); \
    const lds_cptr vp_=vp0+sl_prev; \
    VRD(0); SBAR(); float sacc=(P0[0]+P0[1]); \
    GAPA(C0=__builtin_amdgcn_mfma_f32_32x32x16_bf16(kf[0],qr[0],negm,0,0,0), P0[2],P0[3],P0[4],P0[5],     pw0[0]=PKW(P0,0), pw0[1]=PKW(P0,2), pw0); \
    VRD(4); SBAR(); GAPA(C1=__builtin_amdgcn_mfma_f32_32x32x16_bf16(kf[1],qr[0],negm,0,0,0), P0[6],P0[7],P0[8],P0[9],     pw0[2]=PKW(P0,4), pw0[3]=PKW(P0,6), pw0); \
    VRD(1); SBAR(); GAPA(C0=__builtin_amdgcn_mfma_f32_32x32x16_bf16(kf[2],qr[1],C0,0,0,0),   P0[10],P0[11],P0[12],P0[13], pw1[0]=PKW(P0,8), pw1[1]=PKW(P0,10), pw1); \
    VRD(5); SBAR(); GAPA(C1=__builtin_amdgcn_mfma_f32_32x32x16_bf16(kf[3],qr[1],C1,0,0,0),   P0[14],P0[15],P1[0],P1[1],   pw1[2]=PKW(P0,12),pw1[3]=PKW(P0,14), pw1); \
    VRD(2); SBAR(); GAPA(C0=__builtin_amdgcn_mfma_f32_32x32x16_bf16(kf[4],qr[2],C0,0,0,0),   P1[2],P1[3],P1[4],P1[5],     pw2[0]=PKW(P1,0), pw2[1]=PKW(P1,2), pw2); \
    VRD(6); SBAR(); GAPA(C1=__builtin_amdgcn_mfma_f32_32x32x16_bf16(kf[5],qr[2],C1,0,0,0),   P1[6],P1[7],P1[8],P1[9],     pw2[2]=PKW(P1,4), pw2[3]=PKW(P1,6), pw2); \
    VRD(3); SBAR(); GAPA(C0=__builtin_amdgcn_mfma_f32_32x32x16_bf16(kf[6],qr[3],C0,0,0,0),   P1[10],P1[11],P1[12],P1[13], pw3[0]=PKW(P1,8), pw3[1]=PKW(P1,10), pw3); \
    VRD(7); SBAR(); GAPA(C1=__builtin_amdgcn_mfma_f32_32x32x16_bf16(kf[7],qr[3],C1,0,0,0),   P1[14],P1[15],0.f,0.f,       pw3[2]=PKW(P1,12),pw3[3]=PKW(P1,14), pw3); \
    l_reg+=sacc; \
    if(GK){DMA_K((t)+3,sl_cur);} if(GV){DMA_V((t)+1,sl_next);} \
    CMASK(C0,C1,t); \
    { float a=MX3(C0[0],C0[1],C1[0]),b=MX3(C0[2],C0[3],C1[1]); a=MX3(a,C1[2],C1[3]); \
      _Pragma("unroll") for(int r=4;r<16;r+=4){a=MX3(a,C0[r],C0[r+1]);b=MX3(b,C0[r+2],C0[r+3]);a=MX3(a,C1[r],C1[r+1]);b=MX3(b,C1[r+2],C1[r+3]);} \
      float rm=__builtin_fmaxf(a,b); { auto rr=__builtin_amdgcn_permlane32_swap(__float_as_uint(rm),__float_as_uint(rm),false,false); rm=__builtin_fmaxf(__uint_as_float(rr[0]),__uint_as_float(rr[1])); } \
      resc=false; \
      if(__builtin_expect(__any(rm>(float)THRL),0)){ const float dl=__builtin_fmaxf(rm,0.f); mhat+=dl; \
        _Pragma("unroll") for(int r=0;r<16;++r){C0[r]-=dl;C1[r]-=dl;} \
        const float f=__builtin_amdgcn_exp2f(-dl); l_reg*=f; if(hi==0)wsf[r32]=f; resc=true; } } \
    { const int tn_=(t)+1; if(resc||((tn_&3)==0)){ const int bk_=(tn_<4)?0:((tn_-4)>>2); const bool s_=(tn_<4)||(((selmask>>bk_)&1u)!=0u); const float nm_=s_?-mhat:-INFINITY; \
        _Pragma("unroll") for(int r=0;r<16;++r)negm[r]=nm_; asm volatile("":"+v"(negm)); } } \
    SBAR(); \
    GAPB(o[0]=__builtin_amdgcn_mfma_f32_32x32x16_bf16(PAF(0),VFR(0),o[0],0,0,0), C0,0); \
    GAPB(o[1]=__builtin_amdgcn_mfma_f32_32x32x16_bf16(PAF(0),VFR(4),o[1],0,0,0), C0,4); \
    KRD(GL,0); GAPB(o[0]=__builtin_amdgcn_mfma_f32_32x32x16_bf16(PAF(1),VFR(1),o[0],0,0,0), C0,8); \
    KRD(GL,1); GAPB(o[1]=__builtin_amdgcn_mfma_f32_32x32x16_bf16(PAF(1),VFR(5),o[1],0,0,0), C0,12); \
    KRD(GL,2); GAPB(o[0]=__builtin_amdgcn_mfma_f32_32x32x16_bf16(PAF(2),VFR(2),o[0],0,0,0), C1,0); \
    KRD(GL,3); GAPB(o[1]=__builtin_amdgcn_mfma_f32_32x32x16_bf16(PAF(2),VFR(6),o[1],0,0,0), C1,4); \
    GAPB(o[0]=__builtin_amdgcn_mfma_f32_32x32x16_bf16(PAF(3),VFR(3),o[0],0,0,0), C1,8); \
    GAPB(o[1]=__builtin_amdgcn_mfma_f32_32x32x16_bf16(PAF(3),VFR(7),o[1],0,0,0), C1,12); \
    }while(0)
  int t=1;
  #define ENDW(tt) do{ if((tt)+3<NT){WAIT_BAR(2);} else if((tt)+2<NT){WAIT_BAR(1);} else {WAIT_BAR(0);} }while(0)
  #undef CMASK
  #define CMASK(P0,P1,t) do{int jb_=(t); if(jb_<4)cmask(P0,P1,jb_,qrel,hi);}while(0)
  for(;t<5&&t+1<NT;t+=2){
    STEP(pB0,pB1,pA0,pA1,t,(t+3<NT),(t+1<NT),(t+1<NT));       ENDW(t);   RESC(); ROT();
    STEP(pA0,pA1,pB0,pB1,t+1,(t+4<NT),(t+2<NT),(t+2<NT));     ENDW(t+1); RESC(); ROT();
  }
  #undef CMASK
  #define CMASK(P0,P1,t) do{}while(0)
  for(;t+5<NT;t+=2){
    STEP(pB0,pB1,pA0,pA1,t,true,true,true);     WAIT_BAR(2); RESC(); ROT();
    STEP(pA0,pA1,pB0,pB1,t+1,true,true,true);   WAIT_BAR(2); RESC(); ROT();
  }
  for(;t+1<NT;t+=2){
    STEP(pB0,pB1,pA0,pA1,t,(t+3<NT),(t+1<NT),(t+1<NT));       ENDW(t);   RESC(); ROT();
    STEP(pA0,pA1,pB0,pB1,t+1,(t+4<NT),(t+2<NT),(t+2<NT));     ENDW(t+1); RESC(); ROT();
  }
  #undef CMASK
  #define CMASK(P0,P1,t) do{int jb_=(t); if(jb_<4)cmask(P0,P1,jb_,qrel,hi);}while(0)
  STEP(pB0,pB1,pA0,pA1,NT-1,false,false,false); RESC();
  { float sacc=pB0[0]+pB0[1]; _Pragma("unroll") for(int r=2;r<16;++r)sacc+=pB0[r]; _Pragma("unroll") for(int r=0;r<16;++r)sacc+=pB1[r]; l_reg+=sacc;
    pw0=(u32x4){PKW(pB0,0),PKW(pB0,2),PKW(pB0,4),PKW(pB0,6)};pw1=(u32x4){PKW(pB0,8),PKW(pB0,10),PKW(pB0,12),PKW(pB0,14)};pw2=(u32x4){PKW(pB1,0),PKW(pB1,2),PKW(pB1,4),PKW(pB1,6)};pw3=(u32x4){PKW(pB1,8),PKW(pB1,10),PKW(pB1,12),PKW(pB1,14)};
    SBAR(); pv(o,vb0+sl_cur,PAF(0),PAF(1),PAF(2),PAF(3)); }
  #undef PKW
  #undef PAF
  #undef VFR
  #undef PIN
  #undef MX3
  #undef GAPA
  #undef GAPB
  #undef EX
  #undef VRD
  #undef KRD
  #undef STEP
  #undef ENDW
  {auto rr=__builtin_amdgcn_permlane32_swap(__float_as_uint(l_reg),__float_as_uint(l_reg),false,false);l_reg=__uint_as_float(rr[0])+__uint_as_float(rr[1]);}
  if(hi==0)wsf[32+r32]=l_reg;asm volatile("s_waitcnt lgkmcnt(0)":::"memory");
  float rli[16];
  #pragma unroll
  for(int r=0;r<16;++r)rli[r]=__builtin_amdgcn_rcpf(wsf[32+crow(r,hi)]);
  bf16*Ow=O+(rowbase+q0+wid*QBLK)*DM+h*D;
  { bf16*stg=(bf16*)(shm+LDS_OST)+wid*2048;
    #pragma unroll
    for(int r=0;r<16;++r){const int orow=crow(r,hi);
      #pragma unroll
      for(int d0=0;d0<2;++d0)stg[orow*64+d0*32+r32]=__float2bfloat16(o[d0][r]*rli[r]);}
    asm volatile("s_waitcnt lgkmcnt(0)":::"memory");
    #pragma unroll
    for(int i=0;i<4;++i){const int row=i*8+(lane>>3),ch=lane&7; const u32x4 v=*(const u32x4*)(stg+row*64+ch*8); ATTN_STORE16(Ow+(long)row*DM+ch*8,v);} }
  asm volatile("s_waitcnt lgkmcnt(0)\n\ts_barrier":::"memory");
  #undef DMA_K
  #undef DMA_V
  #undef KT
  #undef CMASK
  #undef START
  #undef RESC
  #undef ROT
}
constexpr int ATTN_LDS_BYTES=LDS_BYTES;
struct AttnTensors { const bf16* Q; const bf16* K; const bf16* V; bf16* O; const unsigned short* KMB; };
struct AttnUnit { int bh; int qb; };
struct StaticOrder {
  int vcu;
  __device__ __forceinline__ explicit StaticOrder(int grid,int block):vcu((block%8)*(grid/8)+block/8){}
  __device__ __forceinline__ bool next(int i,AttnUnit&u)const{ if(i>=4)return false; const int s=vcu&7; u.bh=vcu>>3; u.qb=(i==0)?s:(i==1)?15-s:(i==2)?16+s:31-s; return true; }
  __device__ __forceinline__ void a_ready(const AttnUnit&)const{}
  __device__ __forceinline__ void done(const AttnUnit&)const{}
};
template<class Sched,int THRL=8> __device__ __forceinline__ void attn_phase(char*lds,const AttnTensors&T,const Sched&S){
  AttnUnit u;
  for(int i=0;S.next(i,u);++i){ S.a_ready(u); attn_unit<THRL>(u.bh/NHEAD,u.bh%NHEAD,u.qb,T.Q,T.K,T.V,T.O,T.KMB,lds); S.done(u); }
}
#undef SBAR
#undef WAIT_BAR
}

constexpr int NWAVES = 8;
constexpr int RING_OFF = 0, RING_BYTES = 131072;
constexpr int LDSCTL_OFF = RING_BYTES, MISC_OFF = LDSCTL_OFF + 320;
constexpr int LDS_BYTES = 147456;

typedef GAS unsigned gu32;
#define RLX_AGENT __ATOMIC_RELAXED, __HIP_MEMORY_SCOPE_AGENT
#define XB_TMO      128
#define XB_XCNT(j)  (256  + 64 * (j))
#define XB_XSUB(j)  (1280 + 64 * (j))
#define XB_XGEN(j)  (2304 + 64 * (j))
#define XB_TOP      3328
#define XB_TOPGEN   3392
#define XCD_BAR_WORDS 3456
#define XB_SPIN_CAP (1u << 18)
__device__ __forceinline__ unsigned xb_ld(unsigned* p)              { return __hip_atomic_load(p, __ATOMIC_RELAXED, __HIP_MEMORY_SCOPE_AGENT); }
__device__ __forceinline__ unsigned xb_add(unsigned* p, unsigned v) { return __hip_atomic_fetch_add(p, v, __ATOMIC_RELAXED, __HIP_MEMORY_SCOPE_AGENT); }
__device__ __forceinline__ unsigned xb_xcc_id() { return (unsigned)__builtin_amdgcn_s_getreg((3 << 11) | 20) & 0xFu; }
#define XB_SPIN(cond, bar) do { unsigned _sp = 0; while (cond) { __builtin_amdgcn_s_sleep(1); \
    if ((++_sp & 255u) == 0u) { if (xb_ld(&(bar)[XB_TMO])) break; if (_sp > XB_SPIN_CAP) { atomicAdd(&(bar)[XB_TMO], 1u); break; } } } } while (0)
struct XcdBarrier { unsigned* bar; unsigned x; volatile LAS unsigned* st; };
__device__ __forceinline__ XcdBarrier xcd_barrier_post(unsigned* bar, volatile LAS unsigned* st) {
    XcdBarrier b; b.bar = bar; b.x = xb_xcc_id(); b.st = st;
    if (threadIdx.x == 0) (void)xb_add(&bar[XB_XCNT(b.x)], 1u);
    return b;
}
__device__ __forceinline__ void xcd_barrier_complete(unsigned* bar, unsigned x, unsigned& nloc, unsigned& nx) {
    const unsigned G = gridDim.x * gridDim.y * gridDim.z;
    unsigned sum, cnt, mine, sp = 0u;
    for (;;) {
        sum = 0u; cnt = 0u; mine = 0u;
#pragma unroll
        for (unsigned j = 0; j < 16; ++j) { const unsigned c = xb_ld(&bar[XB_XCNT(j)]); sum += c; cnt += (c > 0u) ? 1u : 0u; mine = (j == x) ? c : mine; }
        if (sum == G) break;
        __builtin_amdgcn_s_sleep(1);
        if ((++sp & 255u) == 0u) { if (xb_ld(&bar[XB_TMO])) break; if (sp > XB_SPIN_CAP) { atomicAdd(&bar[XB_TMO], 1u); break; } }
    }
    nloc = mine > 0u ? mine : 1u; nx = cnt > 0u ? cnt : 1u;
}
__device__ __forceinline__ void xcd_barrier_census(const XcdBarrier& b) {
    if (threadIdx.x == 0) { unsigned nloc, nx; xcd_barrier_complete(b.bar, b.x, nloc, nx); b.st[0] = nloc; b.st[1] = nx; }
}
__device__ __forceinline__ void xcd_barrier(const XcdBarrier& b) {
    asm volatile("s_waitcnt vmcnt(0)" ::: "memory");
    __syncthreads();
    if (threadIdx.x == 0) {
        unsigned* bar = b.bar;
        __builtin_amdgcn_s_waitcnt(0);
        const unsigned nloc = b.st[0], nx = b.st[1];
        const unsigned old = xb_add(&bar[XB_XSUB(b.x)], 1u);
        const unsigned gen = old / nloc;
        if (old + 1u == (gen + 1u) * nloc) {
            __builtin_amdgcn_fence(__ATOMIC_RELEASE, "agent");
            asm volatile("s_waitcnt vmcnt(0)" ::: "memory");
            const unsigned og = xb_add(&bar[XB_TOP], 1u);
            const unsigned tg = og / nx;
            if (og + 1u == (tg + 1u) * nx) xb_add(&bar[XB_TOPGEN], 1u);
            else XB_SPIN(xb_ld(&bar[XB_TOPGEN]) == tg, bar);
            __builtin_amdgcn_fence(__ATOMIC_ACQUIRE, "agent");
            xb_add(&bar[XB_XGEN(b.x)], 1u);
            asm volatile("s_waitcnt vmcnt(0)" ::: "memory");
        } else {
            XB_SPIN(xb_ld(&bar[XB_XGEN(b.x)]) == gen, bar);
            __builtin_amdgcn_fence(__ATOMIC_ACQUIRE, "agent");
            asm volatile("s_waitcnt vmcnt(0)" ::: "memory");
        }
    }
    __syncthreads();
}

struct Frame {
    LAS unsigned char* lds;
    int tid, lane, wave;
    int vcu, G;
};

__device__ __forceinline__ void p0_transpose_item(const float* W, int K, int N, bf16* WT, LAS float* scr, int item, int lane) {
    const int nblk = N / 32, kb = item / nblk, nb = item % nblk, k0 = 64 * kb, n0 = 32 * nb;
#pragma unroll 8
    for (int i = 0; i < 32; ++i) { const int kk = 2 * i + (lane >> 5); scr[kk * 33 + (lane & 31)] = W[(size_t)(k0 + kk) * N + n0 + (lane & 31)]; }
    LDS_WAIT(); asm volatile("" ::: "memory");
    const int c = lane & 7;
#pragma unroll
    for (int j = 0; j < 4; ++j) { const int n = (lane >> 3) + 8 * j; const LAS float* s = scr + (8 * c) * 33 + n;
        u32x4 o; o.x = pk2(s[0 * 33], s[1 * 33]); o.y = pk2(s[2 * 33], s[3 * 33]); o.z = pk2(s[4 * 33], s[5 * 33]); o.w = pk2(s[6 * 33], s[7 * 33]);
        *(GAS u32x4*)(WT + (size_t)(n0 + n) * K + k0 + 8 * c) = o; }
    LDS_WAIT(); asm volatile("" ::: "memory");
}
__device__ __forceinline__ void row_to_bf16(const float* xrow, bf16* orow, int lane) {
    const GAS f32x4* xr = (const GAS f32x4*)xrow + lane;
    GAS u32x2* o8 = (GAS u32x2*)orow + lane;
#pragma unroll
    for (int j = 0; j < 4; ++j) { const f32x4 v = xr[64 * j]; u32x2 w; w.x = pk2(v.x, v.y); w.y = pk2(v.z, v.w); o8[64 * j] = w; }
}

struct Args { const float* in[21]; float* out; unsigned char* ws; int ph_lo, ph_hi; };
typedef __attribute__((address_space(4))) const unsigned long long ka_u64;
__device__ __forceinline__ const float* arg_ptr(int i) { ka_u64* ka = (ka_u64*)__builtin_amdgcn_kernarg_segment_ptr(); asm volatile("" : "+s"(ka)); return (const float*)(const GAS float*)ka[i]; }
#define ARG_IN(i) arg_ptr(i)
#define ARG_OUT() ((float*)arg_ptr(21))
#define ARG_WS() ((unsigned char*)arg_ptr(22))

__device__ __forceinline__ void p0_prologue(Frame& F) {
    PHASE_IDS();
    LAS float* scr = (LAS float*)(F.lds + RING_OFF + wave * 16384);
    const int gw = vcu * NWAVES + wave, NGW = F.G * NWAVES;
    constexpr int I_IN = (DM / 64) * (INC / 32), I_OUT = (MIXW / 64) * (DM / 32), I_SQ = (DM / 64) * (DM / 32);
    constexpr int I_LAYER = I_IN + I_OUT + 4 * I_SQ;
    for (int it = gw; it < DEPTH * I_LAYER; it += NGW) {
        const int l = it / I_LAYER; int r = it % I_LAYER;
        unsigned char* wl = ARG_WS() + WS_W + (size_t)l * W_LAYER;
        const float* W; int K = DM, N = DM; bf16* WT;
        if (r < I_IN) { W = ARG_IN(2) + (size_t)l * DM * INC; N = INC; WT = (bf16*)(wl + WO_IN); }
        else if ((r -= I_IN) < I_OUT) { W = ARG_IN(12) + (size_t)l * MIXW * DM; K = MIXW; WT = (bf16*)(wl + WO_OUT); }
        else { r -= I_OUT; const int which = r / I_SQ; r -= which * I_SQ;
               const float* base = which == 0 ? ARG_IN(15) : (which == 1 ? ARG_IN(16) : (which == 2 ? ARG_IN(17) : ARG_IN(18)));
               W = base + (size_t)l * DM * DM; WT = (bf16*)(wl + WO_Q + (size_t)which * 2 * MiB); }
        p0_transpose_item(W, K, N, WT, scr, r, lane);
    }
    bf16* XB = (bf16*)(ARG_WS() + WS_XB); bf16* MEMB = (bf16*)(ARG_WS() + WS_MEMB);
    for (int m = gw; m < T; m += NGW) row_to_bf16(ARG_IN(0) + (size_t)m * DM, XB + (size_t)m * DM, lane);
    for (int m = gw; m < BATCH * NMEM; m += NGW) row_to_bf16(ARG_IN(1) + (size_t)m * DM, MEMB + (size_t)m * DM, lane);
}

__device__ __forceinline__ void kmean_phase(Frame& F, const bf16* PROJ, bf16* kmean) {
    PHASE_IDS();
    const int gw = vcu * NWAVES + wave, NGW = F.G * NWAVES;
    const int dg = lane & 7, rg = lane >> 3;
    for (int it = gw; it < BATCH * NH * NBLK; it += NGW) {
        const int bh = it >> 5, blk = it & 31, b = bh >> 3, h = bh & 7;
        const bf16* kp = PROJ + ((size_t)(b * SEQ + blk * MBLK + rg)) * INC + C_K + h * HD + dg * 8;
        float acc[8];
#pragma unroll
        for (int e = 0; e < 8; ++e) acc[e] = 0.f;
        for (int i = 0; i < 32; ++i) { const u32x4 w = *(const GAS u32x4*)(kp + (size_t)(8 * i) * INC); float f[8]; unpack8(w, f);
#pragma unroll
            for (int e = 0; e < 8; ++e) acc[e] += f[e]; }
#pragma unroll
        for (int e = 0; e < 8; ++e) { float v = acc[e]; v += __shfl_xor(v, 8); v += __shfl_xor(v, 16); v += __shfl_xor(v, 32); acc[e] = v * (1.f / 256.f); }
        if (rg == 0) *(GAS u32x4*)(kmean + (size_t)it * HD + dg * 8) = pack8(acc);
    }
}

#ifdef MOBA_NAIVE
__device__ __forceinline__ void moba_naive_phase(Frame& F, bf16* PROJ, const bf16* kmean) {
    PHASE_IDS();
    const int gtid = vcu * (NWAVES * 64) + tid, NTH = F.G * NWAVES * 64;
    for (int item = gtid; item < BATCH * NH * SEQ; item += NTH) {
        const int bh = item >> 13, q = item & (SEQ - 1), b = bh >> 3, h = bh & 7, own = q >> 8;
        bf16* qrow = PROJ + ((size_t)(b * SEQ + q)) * INC + C_Q + h * HD;
        float qv[64];
#pragma unroll
        for (int c = 0; c < 8; ++c) unpack8(*(const GAS u32x4*)(qrow + 8 * c), qv + 8 * c);
        float g0 = -3e38f, g1 = -3e38f, g2 = -3e38f; int i0 = 0, i1 = 0, i2 = 0;
        const bf16* km = kmean + (size_t)bh * NBLK * HD;
        for (int j = 0; j < own; ++j) {
            float s = 0.f;
#pragma unroll
            for (int c = 0; c < 8; ++c) { float kf[8]; unpack8(*(const GAS u32x4*)(km + j * HD + 8 * c), kf);
#pragma unroll
                for (int e = 0; e < 8; ++e) s += qv[8 * c + e] * kf[e]; }
            if (s > g0) { g2 = g1; i2 = i1; g1 = g0; i1 = i0; g0 = s; i0 = j; }
            else if (s > g1) { g2 = g1; i2 = i1; g1 = s; i1 = j; }
            else if (s > g2) { g2 = s; i2 = j; }
        }
        const int nsel = own < 3 ? own : 3;
        float m = -1e30f, l = 0.f; float o[64];
#pragma unroll
        for (int d = 0; d < 64; ++d) o[d] = 0.f;
        for (int si = 0; si <= nsel; ++si) {
            int blk, nk;
            if (si < nsel) { blk = (si == 0) ? i0 : ((si == 1) ? i1 : i2); nk = MBLK; } else { blk = own; nk = (q & (MBLK - 1)) + 1; }
            const bf16* kp = PROJ + ((size_t)(b * SEQ + blk * MBLK)) * INC + C_K + h * HD;
            for (int key = 0; key < nk; ++key, kp += INC) {
                float s = 0.f;
#pragma unroll
                for (int c = 0; c < 8; ++c) { float kf[8]; unpack8(*(const GAS u32x4*)(kp + 8 * c), kf);
#pragma unroll
                    for (int e = 0; e < 8; ++e) s += qv[8 * c + e] * kf[e]; }
                if (s > m) { const float f = __builtin_amdgcn_exp2f(m - s); l *= f;
#pragma unroll
                    for (int d = 0; d < 64; ++d) o[d] *= f;
                    m = s; }
                const float p = __builtin_amdgcn_exp2f(s - m); l += p;
                const bf16* vp = kp + (C_V - C_K);
#pragma unroll
                for (int c = 0; c < 8; ++c) { float vf[8]; unpack8(*(const GAS u32x4*)(vp + 8 * c), vf);
#pragma unroll
                    for (int e = 0; e < 8; ++e) o[8 * c + e] += p * vf[e]; }
            }
        }
        const float inv = 1.f / l;
#pragma unroll
        for (int c = 0; c < 8; ++c) { float t8[8];
#pragma unroll
            for (int e = 0; e < 8; ++e) t8[e] = o[8 * c + e] * inv;
            *(GAS u32x4*)(qrow + 8 * c) = pack8(t8); }
    }
}

#endif

struct LruParams { const float *conv_w, *conv_b, *w_a, *b_a, *w_x, *b_x, *lam, *sc_w, *gain; };
template <int PASS>
__device__ __forceinline__ void lru_phase(Frame& F, bf16* PROJ, float* lrus, const LruParams& P) {
    PHASE_IDS();
    LAS float* XL = (LAS float*)(F.lds + RING_OFF);
    LAS float* HL = (LAS float*)(F.lds + RING_OFF + 65536);
    const int c = tid, h = wave, j = lane;
    float wa[64], wx[64];
#pragma unroll
    for (int i = 0; i < 64; ++i) { wa[i] = P.w_a[(size_t)(h * 64 + i) * 64 + j]; wx[i] = P.w_x[(size_t)(h * 64 + i) * 64 + j]; }
    const float ba = P.b_a[c], bx = P.b_x[c], cb = P.conv_b[c];
    const float cw0 = P.conv_w[0 * GW + c], cw1 = P.conv_w[1 * GW + c], cw2 = P.conv_w[2 * GW + c], cw3 = P.conv_w[3 * GW + c];
    const float lamv = P.lam[c];
    const float sp8 = 8.0f * log1pf(__expf(-lamv));
    for (int item = blockIdx.x; item < BATCH * LRU_NT; item += F.G) {
        const int b = item / LRU_NT, tile = item % LRU_NT, t0 = tile * LRU_TILE;
        const size_t rowb = (size_t)b * SEQ;
        float hst = 0.f, aprod = 1.f;
        if (PASS == 2) { const f32x2* sp = (const f32x2*)lrus + (size_t)(b * LRU_NT) * GW + c;
            for (int k = 0; k < tile; ++k) { const f32x2 s = sp[(size_t)k * GW]; hst = s.x * hst + s.y; } }
        float xm3 = 0.f, xm2 = 0.f, xm1 = 0.f;
        if (t0 > 0) { const bf16* xp = PROJ + (rowb + t0) * INC + C_XLRU + c;
            xm3 = bf2f(xp[-3 * (long)INC]); xm2 = bf2f(xp[-2 * (long)INC]); xm1 = bf2f(xp[-1 * (long)INC]); }
        for (int st = 0; st < LRU_TILE / 32; ++st) {
            const int ts = t0 + st * 32;
            { const bf16* xp = PROJ + (rowb + ts) * INC + C_XLRU + c;
              for (int tt = 0; tt < 32; ++tt) { const float x0 = bf2f(xp[(size_t)tt * INC]); XL[tt * GW + c] = cw0 * xm3 + cw1 * xm2 + cw2 * xm1 + cw3 * x0 + cb; xm3 = xm2; xm2 = xm1; xm1 = x0; } }
            __syncthreads();
            for (int tt = 0; tt < 32; ++tt) {
                const LAS f32x4* xr = (const LAS f32x4*)(XL + tt * GW + h * 64);
                float ra = ba, ri = bx;
#pragma unroll
                for (int i4 = 0; i4 < 16; ++i4) { const f32x4 xv = xr[i4];
                    ra += xv.x * wa[4 * i4] + xv.y * wa[4 * i4 + 1] + xv.z * wa[4 * i4 + 2] + xv.w * wa[4 * i4 + 3];
                    ri += xv.x * wx[4 * i4] + xv.y * wx[4 * i4 + 1] + xv.z * wx[4 * i4 + 2] + xv.w * wx[4 * i4 + 3]; }
                const float r = sigmoidf_(ra), ig = sigmoidf_(ri);
                const float la = -sp8 * r, av = __expf(la);
                const float u = sqrtf(-expm1f(2.f * la)) * (ig * XL[tt * GW + c]);
                hst = av * hst + u; aprod *= av;
                if (PASS == 2) HL[tt * GW + c] = hst;
            }
            __syncthreads();
            if (PASS == 2) {
                const int c8 = 8 * lane;
                for (int k = 0; k < 4; ++k) {
                    const int tt = wave + 8 * k, t = ts + tt;
                    bf16* prow = PROJ + (rowb + t) * INC;
                    float v[8], gt[8], y[8];
                    unpack8(*(const GAS u32x4*)(prow + C_Q + c8), v); unpack8(*(const GAS u32x4*)(prow + C_GATT + c8), gt);
                    { float ss = 0.f;
#pragma unroll
                      for (int e = 0; e < 8; ++e) ss += v[e] * v[e];
                      const float rr = rsqrtf(wave_sum(ss) * (1.f / GW) + RMS_EPS);
#pragma unroll
                      for (int e = 0; e < 8; ++e) y[e] = v[e] * rr * P.gain[0 * GW + c8 + e] * (gt[e] * sigmoidf_(gt[e]));
                      *(GAS u32x4*)(prow + C_Q + c8) = pack8(y); }
                    { const LAS f32x4* hp = (const LAS f32x4*)(HL + tt * GW + c8); const f32x4 h0 = hp[0], h1 = hp[1];
                      v[0] = h0.x; v[1] = h0.y; v[2] = h0.z; v[3] = h0.w; v[4] = h1.x; v[5] = h1.y; v[6] = h1.z; v[7] = h1.w;
                      unpack8(*(const GAS u32x4*)(prow + C_GLRU + c8), gt);
                      float ss = 0.f;
#pragma unroll
                      for (int e = 0; e < 8; ++e) ss += v[e] * v[e];
                      const float rr = rsqrtf(wave_sum(ss) * (1.f / GW) + RMS_EPS);
#pragma unroll
                      for (int e = 0; e < 8; ++e) y[e] = v[e] * rr * P.gain[1 * GW + c8 + e] * (gt[e] * sigmoidf_(gt[e]));
                      *(GAS u32x4*)(prow + C_K + c8) = pack8(y); }
                    { float bb[8], cc[8], xx[8], cv[8];
#pragma unroll
                      for (int e = 0; e < 8; ++e) cv[e] = 0.f;
#pragma unroll
                      for (int kk = 0; kk < 3; ++kk) { const int tk = t + kk - 2;
                          if (tk >= 0) { const bf16* pr = PROJ + (rowb + tk) * INC; unpack8(*(const GAS u32x4*)(pr + C_SCC + c8), cc); unpack8(*(const GAS u32x4*)(pr + C_SCX + c8), xx);
#pragma unroll
                              for (int e = 0; e < 8; ++e) cv[e] += P.sc_w[kk * GW + c8 + e] * (cc[e] * xx[e]); } }
                      unpack8(*(const GAS u32x4*)(prow + C_SCB + c8), bb); unpack8(*(const GAS u32x4*)(prow + C_GSC + c8), gt);
                      float ss = 0.f;
#pragma unroll
                      for (int e = 0; e < 8; ++e) { v[e] = bb[e] * cv[e]; ss += v[e] * v[e]; }
                      const float rr = rsqrtf(wave_sum(ss) * (1.f / GW) + RMS_EPS);
#pragma unroll
                      for (int e = 0; e < 8; ++e) y[e] = v[e] * rr * P.gain[2 * GW + c8 + e] * (gt[e] * sigmoidf_(gt[e]));
                      *(GAS u32x4*)(prow + C_V + c8) = pack8(y); }
                }
                __syncthreads();
            }
        }
        if (PASS == 1) { f32x2* sp = (f32x2*)lrus + (size_t)(b * LRU_NT + tile) * GW + c; *sp = (f32x2){aprod, hst}; }
    }
}

__device__ __forceinline__ void ln_phase(Frame& F, float* X, bf16* XB, const float* g, const float* bta) {
    PHASE_IDS();
    const int gw = vcu * NWAVES + wave, NGW = F.G * NWAVES;
    f32x4 gv[4], bv[4];
#pragma unroll
    for (int jj = 0; jj < 4; ++jj) { gv[jj] = ((const GAS f32x4*)g)[lane + 64 * jj]; bv[jj] = ((const GAS f32x4*)bta)[lane + 64 * jj]; }
    for (int m = gw; m < T; m += NGW) {
        GAS f32x4* xr = (GAS f32x4*)(X + (size_t)m * DM) + lane;
        f32x4 v[4]; float s = 0.f;
#pragma unroll
        for (int jj = 0; jj < 4; ++jj) { v[jj] = xr[64 * jj]; s += (v[jj].x + v[jj].y) + (v[jj].z + v[jj].w); }
        const float mean = wave_sum(s) * (1.f / DM); float s2 = 0.f;
#pragma unroll
        for (int jj = 0; jj < 4; ++jj) { v[jj] = v[jj] - mean; s2 += (v[jj].x * v[jj].x + v[jj].y * v[jj].y) + (v[jj].z * v[jj].z + v[jj].w * v[jj].w); }
        const float rstd = rsqrtf(wave_sum(s2) * (1.f / DM) + LN_EPS);
        GAS u32x2* o8 = (GAS u32x2*)(XB + (size_t)m * DM) + lane;
#pragma unroll
        for (int jj = 0; jj < 4; ++jj) { const f32x4 y = v[jj] * rstd * gv[jj] + bv[jj]; xr[64 * jj] = y; u32x2 w; w.x = pk2(y.x, y.y); w.y = pk2(y.z, y.w); o8[64 * jj] = w; }
    }
}

__device__ __forceinline__ void xsoftmax_phase(Frame& F, const float* S, bf16* Pm) {
    PHASE_IDS();
    const int gw = vcu * NWAVES + wave, NGW = F.G * NWAVES;
    for (int it = gw; it < T * 4; it += NGW) {
        const f32x4 v = ((const GAS f32x4*)(S + (size_t)it * 256))[lane];
        const float mx = wave_max(fmaxf(fmaxf(v.x, v.y), fmaxf(v.z, v.w)));
        const float e0 = __builtin_amdgcn_exp2f(v.x - mx), e1 = __builtin_amdgcn_exp2f(v.y - mx), e2 = __builtin_amdgcn_exp2f(v.z - mx), e3 = __builtin_amdgcn_exp2f(v.w - mx);
        const float inv = 1.f / wave_sum((e0 + e1) + (e2 + e3));
        u32x2 w; w.x = pk2(e0 * inv, e1 * inv); w.y = pk2(e2 * inv, e3 * inv);
        ((GAS u32x2*)(Pm + (size_t)it * 256))[lane] = w;
    }
}

#ifndef MK_N_LAUNCHES
#define MK_N_LAUNCHES 1
#endif
constexpr int PH_PER_LAYER = 12, NPHASE = 1 + DEPTH * PH_PER_LAYER;

__global__ void __launch_bounds__(NWAVES * 64, 2) hymba_fwd(Args args) {
    extern __shared__ __attribute__((aligned(16))) unsigned char lds[];
    Frame F;
    F.lds = (LAS unsigned char*)lds;
    volatile LAS unsigned* MISC = (volatile LAS unsigned*)(F.lds + MISC_OFF);
    F.tid = threadIdx.x; F.lane = F.tid & 63; F.wave = __builtin_amdgcn_readfirstlane(F.tid >> 6);
    F.G = gridDim.x; { const int bx = blockIdx.x; F.vcu = (F.G % 8 == 0) ? (bx % 8) * (F.G / 8) + bx / 8 : bx; }
    for (int u = F.tid; u < (LDS_BYTES - LDSCTL_OFF) / 4; u += NWAVES * 64) ((LAS unsigned*)(F.lds + LDSCTL_OFF))[u] = 0u;
    __syncthreads();
    if (MK_N_LAUNCHES == 1) (void)xcd_barrier_post((unsigned*)(ARG_WS() + WS_CTL) + CW_BAR, MISC + 8);
#define MKBAR() XcdBarrier bar; bar.bar = (unsigned*)(ARG_WS() + WS_CTL) + CW_BAR; bar.x = xb_xcc_id(); bar.st = (volatile LAS unsigned*)(F.lds + MISC_OFF) + 8
    const int lo = args.ph_lo, hi = args.ph_hi;
#define IN(k) (lo <= (k) && (k) < hi)
#define SEAM(k) do { if (IN(k) && IN((k) + 1)) { MKBAR(); xcd_barrier(bar); } } while (0)

#define XB ((bf16*)(ARG_WS() + WS_XB))
#define PROJ ((bf16*)(ARG_WS() + WS_PROJ))
#define MEMB ((bf16*)(ARG_WS() + WS_MEMB))
#define Q2 ((bf16*)(ARG_WS() + WS_Q2))
#define SS ((float*)(ARG_WS() + WS_S))
#define PP ((bf16*)(ARG_WS() + WS_P))
#define O2 ((bf16*)(ARG_WS() + WS_O2))
#define KMEAN ((bf16*)(ARG_WS() + WS_KMEAN))
#define LRUS ((float*)(ARG_WS() + WS_LRUS))
#define XR (ARG_OUT())
    if (IN(0)) { p0_prologue(F); }
    if (MK_N_LAUNCHES == 1) { MKBAR(); xcd_barrier_census(bar); }
    SEAM(0);

    for (int l = 0; l < DEPTH; ++l) {
        const int pb = 1 + l * PH_PER_LAYER;
        #define wl (ARG_WS() + WS_W + (size_t)l * W_LAYER)
        #define KMEM ((bf16*)(ARG_WS() + WS_KMEM + (size_t)l * 2 * MiB))
#define VMT ((bf16*)(ARG_WS() + WS_VMT + (size_t)l * 2 * MiB))
        if (IN(pb + 0)) {
            { pg8::Gemm g = pg8::gemm_plain(MEMB, DM, (const bf16*)(wl + WO_K), DM, DM); pg8::StaticOrder S; S.init(BATCH * NMEM, DM, opq_s(F.G), opq_s((int)blockIdx.x));
              pg8::EpiBf16 E{KMEM, DM, 1.f, 0}; pg8::gemm_phase<pg8::EpiBf16, pg8::StaticOrder, true>(F.lds + RING_OFF, g, S, E); }
            { pg8::Gemm g = pg8::gemm_plain((const bf16*)(wl + WO_V), DM, MEMB, DM, DM); pg8::StaticOrder S; S.init(DM, BATCH * NMEM, opq_s(F.G), opq_s((int)blockIdx.x));
              pg8::EpiBf16 E{VMT, BATCH * NMEM, 1.f, 0}; pg8::gemm_phase<pg8::EpiBf16, pg8::StaticOrder, true>(F.lds + RING_OFF, g, S, E); }
            { pg8::Gemm g = pg8::gemm_plain(XB, DM, (const bf16*)(wl + WO_IN), DM, DM); pg8::StaticOrder S; S.init(T, INC, opq_s(F.G), opq_s((int)blockIdx.x));
              pg8::EpiBf16 E{PROJ, INC, C2_ATT, GW}; pg8::gemm_phase<pg8::EpiBf16, pg8::StaticOrder, true>(F.lds + RING_OFF, g, S, E); }
        }
        SEAM(pb + 0);
        if (IN(pb + 1)) { kmean_phase(F, PROJ, KMEAN); LruParams LP{ARG_IN(3) + (size_t)l * 4 * GW, ARG_IN(4) + (size_t)l * GW, ARG_IN(5) + (size_t)l * NH * 64 * 64, ARG_IN(6) + (size_t)l * GW,
                     ARG_IN(7) + (size_t)l * NH * 64 * 64, ARG_IN(8) + (size_t)l * GW, ARG_IN(9) + (size_t)l * GW, ARG_IN(10) + (size_t)l * 3 * GW, ARG_IN(11) + (size_t)l * 3 * GW}; lru_phase<1>(F, PROJ, LRUS, LP); }
        SEAM(pb + 1);
        if (IN(pb + 2)) {
#ifdef MOBA_NAIVE
            moba_naive_phase(F, PROJ, KMEAN);
#else
            bf16* PJ = opq(PROJ); const moba_body::AttnTensors AT{(const moba_body::bf16*)(PJ + C_Q), (const moba_body::bf16*)(PJ + C_K), (const moba_body::bf16*)(PJ + C_V), (moba_body::bf16*)(PJ + C_Q), opq(KMEAN)};
            const moba_body::StaticOrder S((int)opq_s(F.G), opq_s((int)blockIdx.x));
            moba_body::attn_phase<moba_body::StaticOrder>((char*)lds + RING_OFF, AT, S);
#endif
        }
        SEAM(pb + 2);
        if (IN(pb + 3)) { LruParams LP{ARG_IN(3) + (size_t)l * 4 * GW, ARG_IN(4) + (size_t)l * GW, ARG_IN(5) + (size_t)l * NH * 64 * 64, ARG_IN(6) + (size_t)l * GW,
                     ARG_IN(7) + (size_t)l * NH * 64 * 64, ARG_IN(8) + (size_t)l * GW, ARG_IN(9) + (size_t)l * GW, ARG_IN(10) + (size_t)l * 3 * GW, ARG_IN(11) + (size_t)l * 3 * GW}; lru_phase<2>(F, PROJ, LRUS, LP); }
        SEAM(pb + 3);
        if (IN(pb + 4)) {
            pg8::Gemm g = pg8::gemm_plain(PROJ, INC, (const bf16*)(wl + WO_OUT), MIXW, MIXW); pg8::StaticOrder S; S.init(T, DM, opq_s(F.G), opq_s((int)blockIdx.x));
            pg8::EpiF32Res E{l == 0 ? ARG_IN(0) : XR, XR, DM, DN_ALPHA}; pg8::gemm_phase<pg8::EpiF32Res, pg8::StaticOrder, true>(F.lds + RING_OFF, g, S, E);
        }
        SEAM(pb + 4);
        if (IN(pb + 5)) { ln_phase(F, XR, XB, ARG_IN(13) + (size_t)l * DM, ARG_IN(14) + (size_t)l * DM); }
        SEAM(pb + 5);
        if (IN(pb + 6)) {
            pg8::Gemm g = pg8::gemm_plain(XB, DM, (const bf16*)(wl + WO_Q), DM, DM); pg8::StaticOrder S; S.init(T, DM, opq_s(F.G), opq_s((int)blockIdx.x));
            pg8::EpiBf16 E{Q2, DM, C2_X, DM}; pg8::gemm_phase<pg8::EpiBf16, pg8::StaticOrder, true>(F.lds + RING_OFF, g, S, E);
        }
        SEAM(pb + 6);
        if (IN(pb + 7)) {
            pg8::Gemm g; g.A = opq((const bf16*)Q2); g.Bt = opq((const bf16*)KMEM); g.lda = DM; g.ldb = DM; g.K = 256; g.a_pm = (size_t)256 * DM; g.a_pn = 256; g.b_pn = 256; g.b_pb = (size_t)256 * DM;
            pg8::StaticOrder S; S.init(T, DM, opq_s(F.G), opq_s((int)blockIdx.x));
            pg8::EpiF32Res E{nullptr, SS, DM, 0.f}; pg8::gemm_phase<pg8::EpiF32Res, pg8::StaticOrder, true>(F.lds + RING_OFF, g, S, E);
        }
        SEAM(pb + 7);
        if (IN(pb + 8)) { xsoftmax_phase(F, SS, PP); }
        SEAM(pb + 8);
        if (IN(pb + 9)) {
            pg8::Gemm g; g.A = opq((const bf16*)PP); g.Bt = opq((const bf16*)VMT); g.lda = DM; g.ldb = BATCH * NMEM; g.K = 256; g.a_pm = (size_t)256 * DM; g.a_pn = 256; g.b_pn = (size_t)256 * (BATCH * NMEM); g.b_pb = 256;
            pg8::StaticOrder S; S.init(T, DM, opq_s(F.G), opq_s((int)blockIdx.x));
            pg8::EpiBf16 E{O2, DM, 1.f, 0}; pg8::gemm_phase<pg8::EpiBf16, pg8::StaticOrder, true>(F.lds + RING_OFF, g, S, E);
        }
        SEAM(pb + 9);
        if (IN(pb + 10)) {
            pg8::Gemm g = pg8::gemm_plain(O2, DM, (const bf16*)(wl + WO_O), DM, DM); pg8::StaticOrder S; S.init(T, DM, opq_s(F.G), opq_s((int)blockIdx.x));
            pg8::EpiF32Res E{XR, XR, DM, DN_ALPHA}; pg8::gemm_phase<pg8::EpiF32Res, pg8::StaticOrder, true>(F.lds + RING_OFF, g, S, E);
        }
        SEAM(pb + 10);
        if (IN(pb + 11)) { ln_phase(F, XR, XB, ARG_IN(19) + (size_t)l * DM, ARG_IN(20) + (size_t)l * DM); }
        SEAM(pb + 11);
    }
#undef IN
#undef SEAM
#undef MKBAR
#undef XB
#undef PROJ
#undef MEMB
#undef Q2
#undef SS
#undef PP
#undef O2
#undef KMEAN
#undef LRUS
#undef XR
#undef wl
#undef KMEM
#undef VMT
}

extern "C" void kernel_launch(void* const* d_in, const int* in_sizes, int n_in, void* d_out, int out_size, void* d_ws, size_t ws_size, hipStream_t stream) {
    static int grid = 0;
    if (grid == 0) {
        if (n_in != 21 || in_sizes[0] != T * DM || out_size != T * DM || ws_size < WS_END) { fprintf(stderr, "kernel_launch: unexpected shapes (n_in %d, in0 %d, out %d, ws %zu); nothing launched\n", n_in, n_in > 0 ? in_sizes[0] : -1, out_size, ws_size); grid = -1; return; }
        int dev = 0, cus = 0;
        if (hipGetDevice(&dev) != hipSuccess || hipDeviceGetAttribute(&cus, hipDeviceAttributeMultiprocessorCount, dev) != hipSuccess) { grid = -1; return; }
        if (hipFuncSetAttribute((const void*)hymba_fwd, hipFuncAttributeMaxDynamicSharedMemorySize, LDS_BYTES) != hipSuccess) { fprintf(stderr, "kernel_launch: hipFuncSetAttribute failed\n"); grid = -1; return; }
        int per_cu = 0;
        if (hipOccupancyMaxActiveBlocksPerMultiprocessor(&per_cu, (const void*)hymba_fwd, NWAVES * 64, LDS_BYTES) != hipSuccess || per_cu < 1) fprintf(stderr, "kernel_launch: note: occupancy query reports %d\n", per_cu);
        (void)hipGetLastError();
        grid = cus;
    }
    if (grid < 0) return;
    if (hipMemsetAsync((char*)d_ws + WS_CTL, 0, CTL_ZERO_BYTES, stream) != hipSuccess) { fprintf(stderr, "kernel_launch: memset failed\n"); return; }
    Args a{};
    for (int i = 0; i < 21; ++i) a.in[i] = (const float*)d_in[i];
    a.out = (float*)d_out; a.ws = (unsigned char*)d_ws;
#if MK_N_LAUNCHES == 1
    a.ph_lo = 0; a.ph_hi = NPHASE;
    hipLaunchKernelGGL(hymba_fwd, dim3(grid), dim3(NWAVES * 64), LDS_BYTES, stream, a);
#else
    for (int p = 0; p < NPHASE; ++p) { a.ph_lo = p; a.ph_hi = p + 1; hipLaunchKernelGGL(hymba_fwd, dim3(grid), dim3(NWAVES * 64), LDS_BYTES, stream, a); }
#endif
}
```
